# Optimizing an MI355X kernel written in HIP

```python
import jax, jax.numpy as jnp
from jax import lax
import numpy as np

D_MODEL = 2048
BATCH = 8
SEQ = 2048
DEPTH = 1

RET_HEADS = 4
RET_DK = 128
RET_DV = 256
RET_WIDTH = RET_HEADS * RET_DV
HG_HEADS = 8
HG_DK = 128
HG_DV = 128
HG_WIDTH = HG_HEADS * HG_DV
MIX_WIDTH = RET_WIDTH + HG_WIDTH
RET_CHUNK = 128
HG_CHUNK = 64
ROPE_BASE = 10000.0
EPS = 1e-6
ALPHA = (2.0 * DEPTH) ** 0.25
BETA = (8.0 * DEPTH) ** -0.25
RET_LOG2_DECAY = tuple(5.0 + 7.0 * h / (RET_HEADS - 1) for h in range(RET_HEADS))
SPLITS = (RET_HEADS * RET_DK, RET_HEADS * RET_DK, RET_WIDTH, RET_WIDTH,
          HG_HEADS * HG_DK, HG_HEADS * HG_DK, HG_WIDTH, HG_WIDTH)
IN_WIDTH = sum(SPLITS)
SPLIT_POINTS = [int(v) for v in np.cumsum(SPLITS)[:-1]]

kernel_name = "hymba_retnet_hgrn2_deepnorm_adaln"


def _layernorm_noaffine(x):
    xf = x.astype(jnp.float32)
    mu = jnp.mean(xf, axis=-1, keepdims=True)
    var = jnp.mean(jnp.square(xf - mu), axis=-1, keepdims=True)
    return (xf - mu) * lax.rsqrt(var + EPS)


def _rmsnorm(x):
    xf = x.astype(jnp.float32)
    return xf * lax.rsqrt(jnp.mean(jnp.square(xf), axis=-1, keepdims=True) + EPS)


def _rotary(x, positions):
    half = x.shape[-1] // 2
    freqs = ROPE_BASE ** (-jnp.arange(half, dtype=jnp.float32) / half)
    ang = positions.astype(jnp.float32)[..., None] * freqs
    cos = jnp.cos(ang)[:, :, None, :]
    sin = jnp.sin(ang)[:, :, None, :]
    x1, x2 = x[..., :half], x[..., half:]
    return jnp.concatenate([x1 * cos - x2 * sin, x1 * sin + x2 * cos], axis=-1).astype(x.dtype)


def _retention(q, k, v):
    B, T, H, DK = q.shape
    DV = v.shape[-1]
    C = RET_CHUNK
    N = T // C
    lg = jnp.log1p(-jnp.exp2(-jnp.asarray(RET_LOG2_DECAY, jnp.float32)))
    idx = jnp.arange(C, dtype=jnp.float32)
    diff = idx[:, None] - idx[None, :]
    causal = diff >= 0
    d_intra = jnp.where(causal, jnp.exp(jnp.where(causal, diff, 0.0)[None] * lg[:, None, None]), 0.0)
    qc = q.reshape(B, N, C, H, DK)
    kc = k.reshape(B, N, C, H, DK)
    vc = v.reshape(B, N, C, H, DV)
    scores = jnp.einsum('bnihd,bnjhd->bnhij', qc, kc) * d_intra
    intra = jnp.einsum('bnhij,bnjhe->bnihe', scores, vc)
    zeta = jnp.exp((C - 1 - idx)[None, :] * lg[:, None])
    kv = jnp.einsum('bnjhd,hj,bnjhe->nbhde', kc, zeta, vc)
    chunk_decay = jnp.exp(C * lg)[None, :, None, None]

    def step(state, kv_n):
        return chunk_decay * state + kv_n, state

    _, s_prev = lax.scan(step, jnp.zeros((B, H, DK, DV), kv.dtype), kv)
    xi = jnp.exp((idx + 1)[None, :] * lg[:, None])
    inter = jnp.einsum('bnihd,hi,nbhde->bnihe', qc, xi, s_prev)
    return (intra + inter).reshape(B, T, H, DV)


def _hgrn2(q, f_pre, v, lb):
    B, T, H, DK = q.shape
    DV = v.shape[-1]
    C = HG_CHUNK
    N = T // C
    fp = f_pre.astype(jnp.float32)
    log_f = jnp.log(lb + (1.0 - lb) * jax.nn.sigmoid(fp))
    k = (1.0 - lb) * jax.nn.sigmoid(-fp)

    def to_chunks(a):
        return a.reshape(B, N, C, H, a.shape[-1]).swapaxes(0, 1)

    causal = jnp.tril(jnp.ones((C, C), bool))[None, :, :, None, None]

    def step(state, xs):
        qn, kn, vn, gn = xs
        b = jnp.cumsum(gn, axis=1)
        rel = jnp.exp(jnp.where(causal, b[:, :, None] - b[:, None, :], -jnp.inf))
        attn = jnp.einsum('bthd,bshd,btshd->bhts', qn, kn, rel)
        intra = jnp.einsum('bhts,bshe->bthe', attn, vn)
        inter = jnp.einsum('bthd,bhde->bthe', qn * jnp.exp(b), state)
        b_last = b[:, -1]
        new_state = (jnp.exp(b_last)[..., None] * state
                     + jnp.einsum('bshd,bshe->bhde', kn * jnp.exp(b_last[:, None] - b), vn))
        return new_state, intra + inter

    xs = (to_chunks(q.astype(jnp.float32)), to_chunks(k), to_chunks(v.astype(jnp.float32)), to_chunks(log_f))
    _, out = lax.scan(step, jnp.zeros((B, H, DK, DV), jnp.float32), xs)
    return out.swapaxes(0, 1).reshape(B, T, H, DV)


def setup_inputs(seed: int = 0) -> dict:
    key = jax.random.key(seed)
    ks = jax.random.split(key, 12)
    f32 = jnp.float32
    x = jax.random.normal(ks[0], (BATCH, SEQ, D_MODEL), f32)
    c = jax.random.normal(ks[1], (BATCH, D_MODEL), f32)
    offset = jax.random.randint(ks[2], (BATCH, 1), 0, 1024, dtype=jnp.int32)
    positions = (offset + jnp.arange(SEQ, dtype=jnp.int32)[None, :]).astype(jnp.int32)
    w_ada = 0.5 * D_MODEL ** -0.5 * jax.random.normal(ks[3], (DEPTH, D_MODEL, 3 * D_MODEL), f32)
    b_ada = 0.01 * jax.random.normal(ks[4], (DEPTH, 3 * D_MODEL), f32)
    col_scale = jnp.asarray(np.concatenate([
        np.full(n, BETA if j in (2, 6) else 1.0, np.float32) for j, n in enumerate(SPLITS)]))
    w_in = D_MODEL ** -0.5 * jax.random.normal(ks[5], (DEPTH, D_MODEL, IN_WIDTH), f32) * col_scale
    lb_logits = 0.1 * jax.random.normal(ks[6], (DEPTH + 1, HG_HEADS * HG_DK), f32)
    hg_norm_w = 1.0 + 0.02 * jax.random.normal(ks[7], (DEPTH, HG_WIDTH), f32)
    w_out = BETA * MIX_WIDTH ** -0.5 * jax.random.normal(ks[8], (DEPTH, MIX_WIDTH, D_MODEL), f32)
    ln_w = 1.0 + 0.02 * jax.random.normal(ks[9], (DEPTH, D_MODEL), f32)
    ln_b = 0.02 * jax.random.normal(ks[10], (DEPTH, D_MODEL), f32)
    return {"x": x, "c": c, "positions": positions, "w_ada": w_ada, "b_ada": b_ada,
            "w_in": w_in, "lb_logits": lb_logits, "hg_norm_w": hg_norm_w, "w_out": w_out,
            "ln_w": ln_w, "ln_b": ln_b}


def reference(x, c, positions, w_ada, b_ada, w_in, lb_logits, hg_norm_w, w_out, ln_w, ln_b):
    B, T, _ = x.shape
    lb_all = jnp.cumsum(jax.nn.softmax(lb_logits.astype(jnp.float32), axis=0), axis=0)
    cond = jax.nn.silu(c)
    for l in range(DEPTH):
        mod = cond @ w_ada[l] + b_ada[l]
        shift, scale, gate = jnp.split(mod, 3, axis=-1)
        h = (_layernorm_noaffine(x) * (1.0 + scale[:, None]) + shift[:, None]).astype(x.dtype)
        proj = h @ w_in[l]
        rq, rk, rv, rg, hq, hf, hi, hg = jnp.split(proj, SPLIT_POINTS, axis=-1)
        rq = _rotary(rq.reshape(B, T, RET_HEADS, RET_DK), positions) * (RET_DK ** -0.5)
        rk = _rotary(rk.reshape(B, T, RET_HEADS, RET_DK), positions)
        ret = _retention(rq, rk, rv.reshape(B, T, RET_HEADS, RET_DV))
        ret = _rmsnorm(ret).reshape(B, T, RET_WIDTH) * jax.nn.silu(rg.astype(jnp.float32))
        lb = lb_all[l].reshape(HG_HEADS, HG_DK)
        hgo = _hgrn2(hq.reshape(B, T, HG_HEADS, HG_DK), hf.reshape(B, T, HG_HEADS, HG_DK),
                     hi.reshape(B, T, HG_HEADS, HG_DV), lb)
        hgo = (_rmsnorm(hgo) * hg_norm_w[l].reshape(HG_HEADS, HG_DV)).reshape(B, T, HG_WIDTH)
        hgo = hgo * jax.nn.silu(hg.astype(jnp.float32))
        mixed = jnp.concatenate([ret, hgo], axis=-1).astype(x.dtype)
        y = mixed @ w_out[l]
        z = ALPHA * x + gate[:, None] * y
        x = (_layernorm_noaffine(z) * ln_w[l] + ln_b[l]).astype(x.dtype)
    return x
```

```cpp
#include <hip/hip_runtime.h>
#include <cstdio>
#include <cstdint>
#define MK_N_LAUNCHES 8
namespace pg8 {
#define PG8_LAS __attribute__((address_space(3)))
typedef unsigned short bf16_t;
typedef short bf16x8 __attribute__((ext_vector_type(8)));
typedef float f32x4 __attribute__((ext_vector_type(4)));
typedef unsigned u32x4 __attribute__((ext_vector_type(4)));
constexpr int BM = 256, BK = 64, HALF = 128, HTB = HALF * BK * 2  , STAGE_BYTES = 8 * HTB, NXCD = 8, WGM = 8;

__host__ __device__ __forceinline__ int lds_byte(int r, int c) { const int st = (r >> 4) * 2 + (c >> 5), rr = r & 15, cc = c & 31, ob = rr * 64 + cc * 2; return st * 1024 + (ob ^ (((ob >> 9) & 1) << 5)); }
__host__ __device__ __forceinline__ void stage_rc(int b, int& R, int& C) { const int st = b / 1024, sb = b % 1024, swz = sb ^ (((sb >> 9) & 1) << 5); R = (st >> 1) * 16 + swz / 64; C = (st & 1) * 32 + (swz % 64) / 2; }
__host__ __device__ __forceinline__ int perm32(int rho) { const int n = rho >> 4, i = rho & 15; return 8 * (i >> 2) + 4 * n + (i & 3); }

struct Unit { int pm, pn; };
struct Gemm { const bf16_t* A; const bf16_t* Bt; int M, N, K; };

struct StaticOrder {
    int nM, nN, nwg, G, c;
    __host__ __device__ void init(int M, int N, int G_, int c_) { nM = M / BM; nN = N / BM; nwg = nM * nN; G = G_; c = c_; }
    __host__ __device__ bool next(int i, Unit& u) const {
        const long L = (long)i * G + c; if (L >= nwg) return false;
        int wgid = (int)L; { const int q = nwg / NXCD, r = nwg % NXCD, xcd = wgid % NXCD, off = wgid / NXCD; wgid = (xcd < r ? xcd * (q + 1) : r * (q + 1) + (xcd - r) * q) + off; }
        const int nig = WGM * nN, gid = wgid / nig, fm = gid * WGM, gsz = (nM - fm) < WGM ? (nM - fm) : WGM;
        u.pm = fm + ((wgid % nig) % gsz); u.pn = (wgid % nig) / gsz; return true;
    }
    __device__ __forceinline__ void a_ready(const Unit&) const {}
    __device__ __forceinline__ void done(const Unit&) const {}
};

__device__ __forceinline__ unsigned cvt_pk_bf16(float lo, float hi) { unsigned r; asm volatile("v_cvt_pk_bf16_f32 %0, %1, %2" : "=v"(r) : "v"(lo), "v"(hi)); return r; }
struct EpiProj {
    static constexpr bool PERM = true, AFTER_DRAIN = false;
    bf16_t* O; int ldc;
    __device__ __forceinline__ void operator()(const f32x4 (&acc)[2][2][4][2], const Unit& u, int wr, int wc, int fr, int fq) const {
        const int row0 = u.pm * BM + wr * 64 + fr, col0 = u.pn * BM + wc * 32 + 8 * fq;
#pragma unroll
        for (int ai = 0; ai < 2; ++ai)
#pragma unroll
            for (int m = 0; m < 4; ++m) { bf16_t* rowp = O + (size_t)(row0 + ai * HALF + m * 16) * ldc + col0;
#pragma unroll
                for (int bj = 0; bj < 2; ++bj) { const f32x4 v0 = acc[ai][bj][m][0], v1 = acc[ai][bj][m][1];
                    u32x4 w; w.x = cvt_pk_bf16(v0[0], v0[1]); w.y = cvt_pk_bf16(v0[2], v0[3]); w.z = cvt_pk_bf16(v1[0], v1[1]); w.w = cvt_pk_bf16(v1[2], v1[3]);
                    *(u32x4*)(rowp + bj * HALF) = w; } }
    }
};
struct EpiZ {
    static constexpr bool PERM = false, AFTER_DRAIN = false;
    const float* X; float* Z; int ldc; const float* gate; int rows_per_batch; float alpha;
    __device__ __forceinline__ void operator()(const f32x4 (&acc)[2][2][4][2], const Unit& u, int wr, int wc, int fr, int fq) const {
        const int row0 = u.pm * BM + wr * 64 + fr, col0 = u.pn * BM + wc * 32 + 4 * fq;
        const float* g = gate + (size_t)((u.pm * BM) / rows_per_batch) * ldc + col0;
        f32x4 gv[2][2];
#pragma unroll
        for (int bj = 0; bj < 2; ++bj)
#pragma unroll
            for (int n = 0; n < 2; ++n) gv[bj][n] = *(const f32x4*)(g + bj * HALF + n * 16);
#pragma unroll
        for (int ai = 0; ai < 2; ++ai)
#pragma unroll
            for (int m = 0; m < 4; ++m) { const size_t off = (size_t)(row0 + ai * HALF + m * 16) * ldc + col0;
#pragma unroll
                for (int bj = 0; bj < 2; ++bj)
#pragma unroll
                    for (int n = 0; n < 2; ++n) { const f32x4 xv = *(const f32x4*)(X + off + bj * HALF + n * 16);
                        *(f32x4*)(Z + off + bj * HALF + n * 16) = xv * alpha + gv[bj][n] * acc[ai][bj][m][n]; }
                asm volatile("" ::: "memory"); }
    }
};
template <class Epi, class Sched, bool ALIGN_EPI = false, bool SP2 = false>
__device__ __forceinline__ void gemm_phase(PG8_LAS unsigned char* lds, const Gemm g, const Sched& S, const Epi& E) {
    const int tid = threadIdx.x, wid = __builtin_amdgcn_readfirstlane(tid >> 6), lane = tid & 63, wr = wid >> 2, wc = wid & 3, fr = lane & 15, fq = lane >> 4;
    const int K = g.K, nt = K / BK;
    unsigned voffA[2], voffB[2];
#pragma unroll
    for (int i = 0; i < 2; ++i) { int R, C; stage_rc(tid * 16 + i * 8192, R, C); const int Rb = Epi::PERM ? ((R & ~31) + perm32(R & 31)) : R;
        voffA[i] = (unsigned)(R * K + C) * 2u; voffB[i] = (unsigned)(Rb * K + C) * 2u; }
    const size_t kstep = (size_t)(BK * 2);
    const size_t hstep = (size_t)HALF * K * 2;
    const size_t tstep = 2 * hstep;
    const unsigned ldsw = (unsigned)wid * 1024u;
    const int aoff = lds_byte(wr * 64 + fr, fq * 8), boff = lds_byte(wc * 32 + fr, fq * 8);
#define PG8_SA(b, h) (((b) * 2 + (h)) * HTB)
#define PG8_SB(b, h) ((4 + (b) * 2 + (h)) * HTB)
#define PG8_STAGE(bufoff, gbase, voff) do { _Pragma("unroll") for (int _i = 0; _i < 2; ++_i) \
        __builtin_amdgcn_global_load_lds((const unsigned*)((const char*)(gbase) + (voff)[_i]), (PG8_LAS unsigned*)(lds + (bufoff) + ldsw + _i * 8192), 16, 0, 0); } while (0)
#define PG8_LDA(dst, b, h) do { _Pragma("unroll") for (int m = 0; m < 4; ++m) _Pragma("unroll") for (int k = 0; k < 2; ++k) dst[m][k] = *(const PG8_LAS bf16x8*)(lds + PG8_SA(b, h) + aoff + m * 2048 + k * 1024); } while (0)
#define PG8_LDB(dst, b, h) do { _Pragma("unroll") for (int n = 0; n < 2; ++n) _Pragma("unroll") for (int k = 0; k < 2; ++k) dst[n][k] = *(const PG8_LAS bf16x8*)(lds + PG8_SB(b, h) + boff + n * 2048 + k * 1024); } while (0)
#define PG8_MMA(ai, bj, At, Bt) do { __builtin_amdgcn_s_setprio(1); _Pragma("unroll") for (int m = 0; m < 4; ++m) _Pragma("unroll") for (int n = 0; n < 2; ++n) _Pragma("unroll") for (int k = 0; k < 2; ++k) \
        acc[ai][bj][m][n] = __builtin_amdgcn_mfma_f32_16x16x32_bf16(Bt[n][k], At[m][k], acc[ai][bj][m][n], 0, 0, 0); __builtin_amdgcn_s_setprio(0); } while (0)
#define PG8_WAIT_V(n) asm volatile("s_waitcnt vmcnt(" #n ")" ::: "memory")
#define PG8_WAIT_L(n) asm volatile("s_waitcnt lgkmcnt(" #n ")" ::: "memory")
#define PG8_BAR __builtin_amdgcn_s_barrier()
#define PG8_SCHED __builtin_amdgcn_sched_barrier(0)
    Unit cur, nxt; int ui = 0;
    if (!S.next(0, cur)) return;
    f32x4 acc[2][2][4][2];
#pragma unroll
    for (int a = 0; a < 2; ++a)
#pragma unroll
        for (int b = 0; b < 2; ++b)
#pragma unroll
            for (int m = 0; m < 4; ++m)
#pragma unroll
                for (int n = 0; n < 2; ++n) acc[a][b][m][n] = (f32x4){0.f, 0.f, 0.f, 0.f};
    bf16x8 At[4][2], B0[2][2], B1[2][2];
    const char* cA = (const char*)g.A + (size_t)cur.pm * tstep; const char* cB = (const char*)g.Bt + (size_t)cur.pn * tstep;
    S.a_ready(cur);
    if constexpr (SP2) {
        PG8_STAGE(PG8_SB(0, 0), cB, voffB); PG8_STAGE(PG8_SB(0, 1), cB + hstep, voffB); PG8_STAGE(PG8_SA(0, 0), cA, voffA); PG8_STAGE(PG8_SA(0, 1), cA + hstep, voffA);
        if (wr == 1) PG8_BAR;
        PG8_WAIT_V(2); PG8_BAR;
        PG8_STAGE(PG8_SB(1, 0), cB + kstep, voffB); PG8_STAGE(PG8_SA(1, 0), cA + kstep, voffA); PG8_STAGE(PG8_SB(1, 1), cB + hstep + kstep, voffB);
        PG8_WAIT_V(6); PG8_BAR;
    } else {
        PG8_STAGE(PG8_SB(0, 0), cB, voffB); PG8_STAGE(PG8_SA(0, 0), cA, voffA); PG8_STAGE(PG8_SB(0, 1), cB + hstep, voffB); PG8_STAGE(PG8_SA(0, 1), cA + hstep, voffA);
        if (wr == 1) PG8_BAR;
        PG8_WAIT_V(4); PG8_BAR;
        PG8_STAGE(PG8_SB(1, 0), cB + kstep, voffB); PG8_STAGE(PG8_SA(1, 0), cA + kstep, voffA); PG8_STAGE(PG8_SB(1, 1), cB + hstep + kstep, voffB);
        PG8_WAIT_V(6); PG8_BAR;
    }
    for (;;) {
        const bool has_next = S.next(ui + 1, nxt);
        const char* nA = has_next ? (const char*)g.A + (size_t)nxt.pm * tstep : cA; const char* nB = has_next ? (const char*)g.Bt + (size_t)nxt.pn * tstep : cB;
        for (int t = 0; t < nt; t += 2) {
            const bool last = (t == nt - 2);
            const char* a1 = cA + (size_t)(t + 1) * kstep;
            const char* a2 = last ? nA : cA + (size_t)(t + 2) * kstep; const char* b2 = last ? nB : cB + (size_t)(t + 2) * kstep;
            const char* a3 = a2 + kstep; const char* b3 = b2 + kstep;
            if (last && has_next) S.a_ready(nxt);
            if constexpr (SP2) {
            PG8_LDB(B0, 0, 0); PG8_LDB(B1, 0, 1); PG8_SCHED; PG8_LDA(At, 0, 0); PG8_STAGE(PG8_SA(1, 1), a1 + hstep, voffA);
            PG8_WAIT_V(8); PG8_WAIT_L(0); PG8_BAR; PG8_MMA(0, 0, At, B0); PG8_MMA(0, 1, At, B1); PG8_BAR; PG8_SCHED;
            PG8_LDA(At, 0, 1); PG8_STAGE(PG8_SB(0, 0), b2, voffB); PG8_STAGE(PG8_SB(0, 1), b2 + hstep, voffB); PG8_STAGE(PG8_SA(0, 0), a2, voffA);
            PG8_WAIT_V(8); PG8_WAIT_L(0); PG8_BAR; PG8_MMA(1, 0, At, B0); PG8_MMA(1, 1, At, B1); PG8_BAR; PG8_SCHED;
            PG8_LDB(B0, 1, 0); PG8_LDB(B1, 1, 1); PG8_SCHED; PG8_LDA(At, 1, 0); PG8_STAGE(PG8_SA(0, 1), a2 + hstep, voffA);
            PG8_WAIT_V(8); PG8_WAIT_L(0); PG8_BAR; PG8_MMA(0, 0, At, B0); PG8_MMA(0, 1, At, B1); PG8_BAR; PG8_SCHED;
            PG8_LDA(At, 1, 1); PG8_STAGE(PG8_SB(1, 0), b3, voffB); PG8_STAGE(PG8_SB(1, 1), b3 + hstep, voffB); PG8_STAGE(PG8_SA(1, 0), a3, voffA);
            PG8_WAIT_V(8); PG8_WAIT_L(0); PG8_BAR; PG8_MMA(1, 0, At, B0); PG8_MMA(1, 1, At, B1); PG8_BAR; PG8_SCHED;
            } else {
            PG8_LDB(B0, 0, 0); PG8_SCHED; PG8_LDA(At, 0, 0); PG8_STAGE(PG8_SA(1, 1), a1 + hstep, voffA);
            PG8_WAIT_L(8); PG8_BAR; PG8_WAIT_L(0); PG8_MMA(0, 0, At, B0); PG8_BAR; PG8_SCHED;
            PG8_LDB(B1, 0, 1); PG8_STAGE(PG8_SB(0, 0), b2, voffB);
            PG8_BAR; PG8_WAIT_L(0); PG8_MMA(0, 1, At, B1); PG8_BAR;
            PG8_LDA(At, 0, 1); PG8_STAGE(PG8_SA(0, 0), a2, voffA);
            PG8_BAR; PG8_WAIT_L(0); PG8_MMA(1, 0, At, B0); PG8_BAR; PG8_SCHED;
            PG8_STAGE(PG8_SB(0, 1), b2 + hstep, voffB);
            PG8_WAIT_V(6); PG8_BAR; PG8_MMA(1, 1, At, B1); PG8_BAR;
            PG8_LDB(B0, 1, 0); PG8_SCHED; PG8_LDA(At, 1, 0); PG8_STAGE(PG8_SA(0, 1), a2 + hstep, voffA);
            PG8_WAIT_L(8); PG8_BAR; PG8_WAIT_L(0); PG8_MMA(0, 0, At, B0); PG8_BAR; PG8_SCHED;
            PG8_LDB(B1, 1, 1); PG8_STAGE(PG8_SB(1, 0), b3, voffB);
            PG8_BAR; PG8_WAIT_L(0); PG8_MMA(0, 1, At, B1); PG8_BAR;
            PG8_LDA(At, 1, 1); PG8_STAGE(PG8_SA(1, 0), a3, voffA);
            PG8_BAR; PG8_WAIT_L(0); PG8_MMA(1, 0, At, B0); PG8_BAR; PG8_SCHED;
            PG8_STAGE(PG8_SB(1, 1), b3 + hstep, voffB);
            PG8_WAIT_V(6); PG8_BAR; PG8_MMA(1, 1, At, B1); PG8_BAR;
            }
        }
        if constexpr (ALIGN_EPI) { if (wr == 0) PG8_BAR; }
        if constexpr (!Epi::AFTER_DRAIN) { E(acc, cur, wr, wc, fr, fq); S.done(cur); }
        if (!has_next) break;
#pragma unroll
        for (int a = 0; a < 2; ++a)
#pragma unroll
            for (int b = 0; b < 2; ++b)
#pragma unroll
                for (int m = 0; m < 4; ++m)
#pragma unroll
                    for (int n = 0; n < 2; ++n) acc[a][b][m][n] = (f32x4){0.f, 0.f, 0.f, 0.f};
        cur = nxt; cA = nA; cB = nB; ++ui;
        if constexpr (ALIGN_EPI) { if (wr == 1) PG8_BAR; }
    }
    PG8_WAIT_V(0);
    if constexpr (!ALIGN_EPI) { if (wr == 0) PG8_BAR; }
    PG8_BAR;
    if constexpr (Epi::AFTER_DRAIN) { E.fused(acc, cur, wr, wc, fr, fq, lds, wid, lane); S.done(cur); }
#undef PG8_SA
#undef PG8_SB
#undef PG8_STAGE
#undef PG8_LDA
#undef PG8_LDB
#undef PG8_MMA
#undef PG8_WAIT_V
#undef PG8_WAIT_L
#undef PG8_BAR
#undef PG8_SCHED
}
}

constexpr int NWAVES = 8, NTHR = NWAVES * 64;
constexpr int BATCH = 8, T = 2048, D = 2048, M = BATCH * T, NIN = 7168, NMOD = 3 * D;
constexpr int RH = 4, RDK = 128, RDV = 256, RC = 128, RN = T / RC;
constexpr int HH = 8, HDK = 128, HDV = 128, HC = 64, HN = T / HC;
constexpr int C_RQ = 0, C_RK = 512, C_RV = 1024, C_RG = 2048, C_HQ = 3072, C_HF = 4096, C_HI = 5120, C_HG = 6144;
constexpr float EPS = 1e-6f;
constexpr float ALPHA = 1.189207115002721f;
constexpr int MOD_KS = 16;
#ifndef MK_N_LAUNCHES
#define MK_N_LAUNCHES 1
#endif
constexpr int NPHASE = 8;
constexpr int N_LAUNCHES = MK_N_LAUNCHES;

constexpr size_t MiB = 1u << 20;
constexpr size_t WS_CTL = 0, CTL_ZERO_BYTES = 64 * 1024;
constexpr size_t WS_LB = 1 * MiB;
constexpr size_t WS_GATE = WS_LB + 64 * 1024;
constexpr size_t WS_LAM = 2 * MiB;
constexpr size_t WS_MODP = 3 * MiB;
constexpr size_t WS_ROPE = 6 * MiB;
constexpr size_t WS_WIN = 14 * MiB;
constexpr size_t WS_WOUT = 43 * MiB;
constexpr size_t WS_H = 52 * MiB;
constexpr size_t WS_PROJ = 116 * MiB;
constexpr size_t WS_RS = 340 * MiB;
constexpr size_t WS_HS = 372 * MiB;
constexpr size_t WS_END = 436 * MiB;
static_assert(WS_WIN + (size_t)NIN * D * 2 <= WS_WOUT && WS_WOUT + (size_t)D * D * 2 <= WS_H && WS_H + (size_t)M * D * 2 <= WS_PROJ && WS_PROJ + (size_t)M * NIN * 2 <= WS_RS &&
              WS_RS + (size_t)BATCH * RN * RH * RDV * RDK * 2 <= WS_HS && WS_HS + (size_t)BATCH * HN * HH * HDV * HDK * 2 <= WS_END && WS_MODP + (size_t)MOD_KS * BATCH * NMOD * 4 <= WS_ROPE &&
              WS_ROPE + (size_t)BATCH * T * 128 * 4 <= WS_WIN, "d_ws map");
constexpr int CW_BAR = 1024;

constexpr int RING_OFF = 0, RING_BYTES = 131072;
constexpr int LDSCTL_OFF = RING_BYTES, MISC_OFF = LDSCTL_OFF + 320;
constexpr int LDS_BYTES = 147456;

#define GAS __attribute__((address_space(1)))
#define LAS __attribute__((address_space(3)))
typedef unsigned short bf16;
typedef unsigned v4u __attribute__((ext_vector_type(4)));
typedef unsigned v2u __attribute__((ext_vector_type(2)));
typedef float f32x4 __attribute__((ext_vector_type(4)));
typedef GAS unsigned gu32;
#define RLX_AGENT __ATOMIC_RELAXED, __HIP_MEMORY_SCOPE_AGENT
#define LDS_WAIT() asm volatile("s_waitcnt lgkmcnt(0)" ::: "memory")
#define VM_WAIT() asm volatile("s_waitcnt vmcnt(0)" ::: "memory")
__device__ __forceinline__ unsigned f2bf(float f) { unsigned u = __builtin_bit_cast(unsigned, f); return (u + 0x7fffu + ((u >> 16) & 1u)) >> 16; }
__device__ __forceinline__ unsigned pk2(float lo, float hi) { return f2bf(lo) | (f2bf(hi) << 16); }
__device__ __forceinline__ float bf2f(unsigned short b) { return __builtin_bit_cast(float, (unsigned)b << 16); }
__device__ __forceinline__ float bflo(unsigned w) { return __builtin_bit_cast(float, w << 16); }
__device__ __forceinline__ float bfhi(unsigned w) { return __builtin_bit_cast(float, w & 0xffff0000u); }
__device__ __forceinline__ float wave_sum(float v) {
#pragma unroll
    for (int o = 1; o < 64; o <<= 1) v += __shfl_xor(v, o);
    return v;
}
__device__ __forceinline__ float sigmoidf_(float x) { return 1.0f / (1.0f + __expf(-x)); }
__device__ __forceinline__ float siluf_(float x) { return x / (1.0f + __expf(-x)); }
__device__ __forceinline__ float ret_log2_gamma(int h) {
    const float e = (float)(5.0 + 7.0 * (double)h / 3.0);
    return log1pf(-exp2f(-e)) * 1.4426950408889634f;
}
#define XB_TMO      128
#define XB_XCNT(j)  (256  + 64 * (j))
#define XB_XSUB(j)  (1280 + 64 * (j))
#define XB_XGEN(j)  (2304 + 64 * (j))
#define XB_TOP      3328
#define XB_TOPGEN   3392
#define XCD_BAR_WORDS 3456
#define XB_SPIN_CAP (1u << 18)

__device__ __forceinline__ unsigned xb_ld(unsigned* p)              { return __hip_atomic_load(p, __ATOMIC_RELAXED, __HIP_MEMORY_SCOPE_AGENT); }
__device__ __forceinline__ unsigned xb_add(unsigned* p, unsigned v) { return __hip_atomic_fetch_add(p, v, __ATOMIC_RELAXED, __HIP_MEMORY_SCOPE_AGENT); }
__device__ __forceinline__ unsigned xb_xcc_id() { return (unsigned)__builtin_amdgcn_s_getreg((3 << 11) | 20) & 0xFu; }
#define XB_SPIN(cond, bar) do { unsigned _sp = 0; while (cond) { __builtin_amdgcn_s_sleep(1); \
    if ((++_sp & 255u) == 0u) { if (xb_ld(&(bar)[XB_TMO])) break; if (_sp > XB_SPIN_CAP) { atomicAdd(&(bar)[XB_TMO], 1u); break; } } } } while (0)

struct XcdBarrier {
    unsigned* bar; unsigned x;
    volatile LAS unsigned* st;
};

__device__ __forceinline__ XcdBarrier xcd_barrier_post(unsigned* bar, volatile LAS unsigned* st) {
    XcdBarrier b; b.bar = bar; b.x = xb_xcc_id(); b.st = st;
    if (threadIdx.x == 0) (void)xb_add(&bar[XB_XCNT(b.x)], 1u);
    return b;
}
__device__ __forceinline__ void xcd_barrier_complete(unsigned* bar, unsigned x, unsigned& nloc, unsigned& nx) {
    const unsigned G = gridDim.x * gridDim.y * gridDim.z;
    unsigned sum, cnt, mine, sp = 0u;
    for (;;) {
        sum = 0u; cnt = 0u; mine = 0u;
#pragma unroll
        for (unsigned j = 0; j < 16; ++j) { const unsigned c = xb_ld(&bar[XB_XCNT(j)]); sum += c; cnt += (c > 0u) ? 1u : 0u; mine = (j == x) ? c : mine; }
        if (sum == G) break;
        __builtin_amdgcn_s_sleep(1);
        if ((++sp & 255u) == 0u) { if (xb_ld(&bar[XB_TMO])) break; if (sp > XB_SPIN_CAP) { atomicAdd(&bar[XB_TMO], 1u); break; } }
    }
    nloc = mine > 0u ? mine : 1u; nx = cnt > 0u ? cnt : 1u;
}

__device__ __forceinline__ void xcd_barrier(const XcdBarrier& b) {
    asm volatile("s_waitcnt vmcnt(0)" ::: "memory");
    __syncthreads();
    if (threadIdx.x == 0) {
        unsigned* bar = b.bar;
        __builtin_amdgcn_s_waitcnt(0);
        unsigned nloc = b.st[0], nx = b.st[1];
        if (nloc == 0u) { xcd_barrier_complete(bar, b.x, nloc, nx); b.st[0] = nloc; b.st[1] = nx; }
        const unsigned old = xb_add(&bar[XB_XSUB(b.x)], 1u);
        const unsigned gen = old / nloc;
        if (old + 1u == (gen + 1u) * nloc) {
            __builtin_amdgcn_fence(__ATOMIC_RELEASE, "agent");
            asm volatile("s_waitcnt vmcnt(0)" ::: "memory");
            const unsigned og = xb_add(&bar[XB_TOP], 1u);
            const unsigned tg = og / nx;
            if (og + 1u == (tg + 1u) * nx) xb_add(&bar[XB_TOPGEN], 1u);
            else XB_SPIN(xb_ld(&bar[XB_TOPGEN]) == tg, bar);
            __builtin_amdgcn_fence(__ATOMIC_ACQUIRE, "agent");
            xb_add(&bar[XB_XGEN(b.x)], 1u);
            asm volatile("s_waitcnt vmcnt(0)" ::: "memory");
        } else {
            XB_SPIN(xb_ld(&bar[XB_XGEN(b.x)]) == gen, bar);
            __builtin_amdgcn_fence(__ATOMIC_ACQUIRE, "agent");
            asm volatile("s_waitcnt vmcnt(0)" ::: "memory");
        }
    }
    __syncthreads();
}

struct Frame {
    LAS unsigned char* lds;
    volatile LAS unsigned* MISC;
    gu32* ctl;
    int tid, lane, wave, vcu, G;
    const float *x, *c, *w_ada, *b_ada, *w_in, *lb_logits, *hg_norm_w, *w_out, *ln_w, *ln_b;
    const int* positions;
    float* out;
    float *LB, *GATE, *LAM, *MODP, *ROPE;
    bf16 *WIN, *WOUT, *HB, *PROJ, *RS, *HS;
};

__device__ __forceinline__ int win_dst_row(int n) { return n; }
__device__ __forceinline__ float win_col_scale(int n) { return n < C_RK ? 0.08838834764831845f : 1.0f; }

template <bool IS_WIN>
__device__ __forceinline__ void p0_transpose_item(const float* W, int K, int N, bf16* WT, LAS float* scr, int item, int lane) {
    const int nblk = N / 32, kb = item / nblk, nb = item % nblk, k0 = 64 * kb, n0 = 32 * nb;
#pragma unroll 8
    for (int i = 0; i < 32; ++i) { const int kk = 2 * i + (lane >> 5); scr[kk * 33 + (lane & 31)] = W[(size_t)(k0 + kk) * N + n0 + (lane & 31)]; }
    LDS_WAIT(); asm volatile("" ::: "memory");
    const int c = lane & 7;
#pragma unroll
    for (int j = 0; j < 4; ++j) { const int n = (lane >> 3) + 8 * j; const LAS float* s = scr + (8 * c) * 33 + n;
        const float sc = IS_WIN ? win_col_scale(n0 + n) : 1.0f; const int drow = IS_WIN ? win_dst_row(n0 + n) : (n0 + n);
        v4u o; o.x = pk2(s[0 * 33] * sc, s[1 * 33] * sc); o.y = pk2(s[2 * 33] * sc, s[3 * 33] * sc); o.z = pk2(s[4 * 33] * sc, s[5 * 33] * sc); o.w = pk2(s[6 * 33] * sc, s[7 * 33] * sc);
        *(GAS v4u*)(WT + (size_t)drow * K + k0 + 8 * c) = o; }
    LDS_WAIT(); asm volatile("" ::: "memory");
}

__device__ __forceinline__ void p0_prologue(Frame& F) {
    {
        LAS float* sc = (LAS float*)(F.lds + RING_OFF);
        constexpr int KS = D / MOD_KS, NCB = NMOD / NTHR;
        for (int it = blockIdx.x; it < MOD_KS * NCB; it += F.G) {
            const int s = it / NCB, cb = it % NCB, k0 = s * KS, n = cb * NTHR + F.tid;
            __syncthreads();
            for (int i = F.tid; i < BATCH * KS; i += NTHR) { const int b = i / KS, k = i % KS; sc[i] = siluf_(F.c[(size_t)b * D + k0 + k]); }
            __syncthreads();
            float acc[BATCH];
#pragma unroll
            for (int b = 0; b < BATCH; ++b) acc[b] = (s == 0) ? F.b_ada[n] : 0.f;
#pragma unroll 4
            for (int k = 0; k < KS; ++k) { const float w = F.w_ada[(size_t)(k0 + k) * NMOD + n];
#pragma unroll
                for (int b = 0; b < BATCH; ++b) acc[b] += sc[b * KS + k] * w; }
#pragma unroll
            for (int b = 0; b < BATCH; ++b) F.MODP[((size_t)s * BATCH + b) * NMOD + n] = acc[b];
        }
        __syncthreads();
    }
    {
        LAS float* scr = (LAS float*)(F.lds + RING_OFF + F.wave * 16384);
        const int gw = F.vcu * NWAVES + F.wave, NGW = F.G * NWAVES;
        constexpr int I_IN = (D / 64) * (NIN / 32), I_OUT = (D / 64) * (D / 32);
        for (int it = gw; it < I_IN + I_OUT; it += NGW) {
            if (it < I_IN) p0_transpose_item<true>(F.w_in, D, NIN, F.WIN, scr, it, F.lane);
            else p0_transpose_item<false>(F.w_out, D, D, F.WOUT, scr, it - I_IN, F.lane);
        }
    }
    {
        const int gt = blockIdx.x * NTHR + F.tid, NGT = F.G * NTHR;
        for (int idx = gt; idx < BATCH * T * 64; idx += NGT) {
            const int i = idx & 63, bt = idx >> 6;
            const float freq = (float)pow(10000.0, -(double)i / 64.0);
            const float ang = (float)F.positions[bt] * freq;
            double sn, cs; sincos((double)ang, &sn, &cs);
            F.ROPE[(size_t)bt * 128 + i] = (float)cs; F.ROPE[(size_t)bt * 128 + 64 + i] = (float)sn;
        }
        for (int idx = gt; idx < HH * HDK; idx += NGT) { const float l0 = F.lb_logits[idx], l1 = F.lb_logits[HH * HDK + idx]; const float mx = fmaxf(l0, l1);
            const float e0 = expf(l0 - mx), e1 = expf(l1 - mx); F.LB[idx] = e0 / (e0 + e1); }
    }
}

__device__ __forceinline__ void p1_modulate(Frame& F) {
    LAS float* sh = (LAS float*)(F.lds + RING_OFF);
    constexpr int ROWS_WG = 64;
    for (int blk = blockIdx.x; blk < M / ROWS_WG; blk += F.G) {
        const int b = (blk * ROWS_WG) / T;
        __syncthreads();
        for (int i = F.tid; i < 2 * D; i += NTHR) { float s = 0.f;
#pragma unroll
            for (int ks = 0; ks < MOD_KS; ++ks) s += F.MODP[((size_t)ks * BATCH + b) * NMOD + i];
            sh[i] = s; }
        if ((blk * ROWS_WG) % T == 0) {
            for (int i = F.tid; i < D; i += NTHR) { float s = 0.f;
#pragma unroll
                for (int ks = 0; ks < MOD_KS; ++ks) s += F.MODP[((size_t)ks * BATCH + b) * NMOD + 2 * D + i];
                F.GATE[(size_t)b * D + i] = s; }
        }
        __syncthreads();
        for (int r = F.wave; r < ROWS_WG; r += NWAVES) {
            const int row = blk * ROWS_WG + r;
            const GAS f32x4* xr = (const GAS f32x4*)(F.x + (size_t)row * D) + F.lane;
            f32x4 v[8]; float s = 0.f;
#pragma unroll
            for (int j = 0; j < 8; ++j) { v[j] = xr[64 * j]; s += (v[j].x + v[j].y) + (v[j].z + v[j].w); }
            const float mean = wave_sum(s) * (1.f / D); float s2 = 0.f;
#pragma unroll
            for (int j = 0; j < 8; ++j) { v[j] = v[j] - mean; s2 += (v[j].x * v[j].x + v[j].y * v[j].y) + (v[j].z * v[j].z + v[j].w * v[j].w); }
            const float rstd = 1.f / sqrtf(wave_sum(s2) * (1.f / D) + EPS);
            GAS v2u* o8 = (GAS v2u*)(F.HB + (size_t)row * D) + F.lane;
#pragma unroll
            for (int j = 0; j < 8; ++j) { const int c0 = 4 * F.lane + 256 * j;
                const f32x4 sf = *(const LAS f32x4*)(sh + c0), sc = *(const LAS f32x4*)(sh + D + c0);
                const f32x4 h = v[j] * rstd * (sc + 1.0f) + sf;
                v2u w; w.x = pk2(h.x, h.y); w.y = pk2(h.z, h.w); o8[64 * j] = w; }
        }
    }
    __syncthreads();
}

__device__ __forceinline__ void p3_transform_naive(Frame& F) {
    const long gt = (long)blockIdx.x * NTHR + F.tid, NGT = (long)F.G * NTHR;
    for (long idx = gt; idx < (long)M * 512; idx += NGT) {
        const int i = idx & 63, head = (idx >> 6) & 3, which = (idx >> 8) & 1; const int row = (int)(idx >> 9);
        bf16* p = F.PROJ + (size_t)row * NIN + (which ? C_RK : C_RQ) + head * RDK + i;
        const float x1 = bf2f(p[0]), x2 = bf2f(p[64]);
        const float cs = F.ROPE[(size_t)row * 128 + i], sn = F.ROPE[(size_t)row * 128 + 64 + i];
        const int tl = row % RC;
        const float lg = ret_log2_gamma(head);
        const float sc = exp2f((which ? -1.f : 1.f) * (float)(tl + 1) * lg);
        p[0] = (bf16)f2bf((x1 * cs - x2 * sn) * sc); p[64] = (bf16)f2bf((x1 * sn + x2 * cs) * sc);
    }
    for (long idx = gt; idx < (long)M * 2048; idx += NGT) {
        const int cc = idx & 2047; const int row = (int)(idx >> 11);
        bf16* p = F.PROJ + (size_t)row * NIN + (cc < 1024 ? C_RG + cc : C_HG + cc - 1024);
        p[0] = (bf16)f2bf(siluf_(bf2f(p[0])));
    }
    for (long idx = gt; idx < (long)BATCH * HN * HH * HDK; idx += NGT) {
        const int d = idx & 127, h = (idx >> 7) & 7, n = (idx >> 10) & 31, b = (int)(idx >> 15);
        const float lb = F.LB[h * HDK + d];
        float bs = 0.f;
        for (int s = 0; s < HC; ++s) {
            const size_t row = (size_t)b * T + n * HC + s;
            bf16* pq = F.PROJ + row * NIN + C_HQ + h * HDK + d; bf16* pf = F.PROJ + row * NIN + C_HF + h * HDK + d;
            const float q = bf2f(pq[0]), fp = bf2f(pf[0]);
            const float sg = 1.0f / (1.0f + expf(-fp)), sgn = 1.0f / (1.0f + expf(fp));
            const float f = lb + (1.0f - lb) * sg;
            bs += logf(f);
            pq[0] = (bf16)f2bf(q * expf(bs)); pf[0] = (bf16)f2bf((1.0f - lb) * sgn * expf(-bs));
        }
        F.LAM[idx] = expf(bs);
    }
}

__device__ __forceinline__ void p4_state_naive(Frame& F) {
    const long gt = (long)blockIdx.x * NTHR + F.tid, NGT = (long)F.G * NTHR;
    for (long idx = gt; idx < (long)BATCH * RH * RDV * RDK; idx += NGT) {
        const int d = idx & 127, e = (idx >> 7) & 255, h = (idx >> 15) & 3, b = (int)(idx >> 17);
        const float cd = exp2f((float)RC * ret_log2_gamma(h));
        float S = 0.f;
        for (int n = 0; n < RN; ++n) {
            F.RS[((((size_t)b * RN + n) * RH + h) * RDV + e) * RDK + d] = (bf16)f2bf(S);
            for (int j = 0; j < RC; ++j) { const size_t row = (size_t)b * T + n * RC + j;
                S += bf2f(F.PROJ[row * NIN + C_RK + h * RDK + d]) * bf2f(F.PROJ[row * NIN + C_RV + h * RDV + e]); }
            S *= cd;
        }
    }
    for (long idx = gt; idx < (long)BATCH * HH * HDV * HDK; idx += NGT) {
        const int d = idx & 127, e = (idx >> 7) & 127, h = (idx >> 14) & 7, b = (int)(idx >> 17);
        float S = 0.f;
        for (int n = 0; n < HN; ++n) {
            F.HS[((((size_t)b * HN + n) * HH + h) * HDV + e) * HDK + d] = (bf16)f2bf(S);
            for (int j = 0; j < HC; ++j) { const size_t row = (size_t)b * T + n * HC + j;
                S += bf2f(F.PROJ[row * NIN + C_HF + h * HDK + d]) * bf2f(F.PROJ[row * NIN + C_HI + h * HDV + e]); }
            S *= F.LAM[(((size_t)b * HN + n) * HH + h) * HDK + d];
        }
    }
}

template <int C, int DV>
__device__ __forceinline__ void p5_item_naive(Frame& F, const bf16* qt, const bf16* kt, const bf16* v, const bf16* g, const bf16* ST, const float* nw, bf16* mixed) {
    LAS float* P = (LAS float*)(F.lds + RING_OFF);
    LAS float* O = P + C * (C + 1);
    __syncthreads();
    for (int idx = F.tid; idx < C * C; idx += NTHR) {
        const int i = idx / C, j = idx % C; float s = 0.f;
        if (j <= i) { const v4u* a = (const v4u*)(qt + (size_t)i * NIN); const v4u* bq = (const v4u*)(kt + (size_t)j * NIN);
            for (int k = 0; k < 16; ++k) { const v4u av = a[k], bv = bq[k];
                s += bflo(av.x) * bflo(bv.x) + bfhi(av.x) * bfhi(bv.x) + bflo(av.y) * bflo(bv.y) + bfhi(av.y) * bfhi(bv.y)
                   + bflo(av.z) * bflo(bv.z) + bfhi(av.z) * bfhi(bv.z) + bflo(av.w) * bflo(bv.w) + bfhi(av.w) * bfhi(bv.w); } }
        P[i * (C + 1) + j] = s;
    }
    __syncthreads();
    for (int i0 = 0; i0 < C; i0 += 32) {
        const int ii = F.tid >> 4, el = F.tid & 15, i = i0 + ii;
        for (int e = el; e < DV; e += 16) {
            float s = 0.f;
            for (int j = 0; j <= i; ++j) s += P[i * (C + 1) + j] * bf2f(v[(size_t)j * NIN + e]);
            const v4u* a = (const v4u*)(qt + (size_t)i * NIN); const v4u* st = (const v4u*)(ST + (size_t)e * 128);
            for (int k = 0; k < 16; ++k) { const v4u av = a[k], bv = st[k];
                s += bflo(av.x) * bflo(bv.x) + bfhi(av.x) * bfhi(bv.x) + bflo(av.y) * bflo(bv.y) + bfhi(av.y) * bfhi(bv.y)
                   + bflo(av.z) * bflo(bv.z) + bfhi(av.z) * bfhi(bv.z) + bflo(av.w) * bflo(bv.w) + bfhi(av.w) * bfhi(bv.w); }
            O[ii * DV + e] = s;
        }
        __syncthreads();
        for (int r = F.wave; r < 32; r += NWAVES) {
            float ss = 0.f;
            for (int e = F.lane; e < DV; e += 64) { const float o = O[r * DV + e]; ss += o * o; }
            const float rstd = 1.0f / sqrtf(wave_sum(ss) * (1.0f / DV) + EPS);
            for (int e = F.lane; e < DV; e += 64) { const float o = O[r * DV + e] * rstd * (nw ? nw[e] : 1.0f) * bf2f(g[(size_t)(i0 + r) * NIN + e]);
                mixed[(size_t)(i0 + r) * D + e] = (bf16)f2bf(o); }
        }
        __syncthreads();
    }
}
__device__ __forceinline__ void p5_output_naive(Frame& F) {
    constexpr int NR = BATCH * RN * RH, NHI = BATCH * HN * HH;
    for (int it = blockIdx.x; it < NR + NHI; it += F.G) {
        if (it < NR) { const int h = it % RH, n = (it / RH) % RN, b = it / (RH * RN); const size_t row0 = (size_t)b * T + n * RC;
            const bf16* base = F.PROJ + row0 * NIN;
            p5_item_naive<RC, RDV>(F, base + C_RQ + h * RDK, base + C_RK + h * RDK, base + C_RV + h * RDV, base + C_RG + h * RDV,
                                   F.RS + (((size_t)b * RN + n) * RH + h) * RDV * RDK, nullptr, F.HB + row0 * D + h * RDV);
        } else { const int i2 = it - NR; const int h = i2 % HH, n = (i2 / HH) % HN, b = i2 / (HH * HN); const size_t row0 = (size_t)b * T + n * HC;
            const bf16* base = F.PROJ + row0 * NIN;
            p5_item_naive<HC, HDV>(F, base + C_HQ + h * HDK, base + C_HF + h * HDK, base + C_HI + h * HDV, base + C_HG + h * HDV,
                                   F.HS + (((size_t)b * HN + n) * HH + h) * HDV * HDK, F.hg_norm_w + h * HDV, F.HB + row0 * D + RH * RDV + h * HDV);
        }
    }
    __syncthreads();
}

__device__ __forceinline__ void p7_final_ln(Frame& F) {
    const int gw = F.vcu * NWAVES + F.wave, NGW = F.G * NWAVES;
    for (int row = gw; row < M; row += NGW) {
        GAS f32x4* zr = (GAS f32x4*)(F.out + (size_t)row * D) + F.lane;
        f32x4 v[8]; float s = 0.f;
#pragma unroll
        for (int j = 0; j < 8; ++j) { v[j] = zr[64 * j]; s += (v[j].x + v[j].y) + (v[j].z + v[j].w); }
        const float mean = wave_sum(s) * (1.f / D); float s2 = 0.f;
#pragma unroll
        for (int j = 0; j < 8; ++j) { v[j] = v[j] - mean; s2 += (v[j].x * v[j].x + v[j].y * v[j].y) + (v[j].z * v[j].z + v[j].w * v[j].w); }
        const float rstd = 1.f / sqrtf(wave_sum(s2) * (1.f / D) + EPS);
#pragma unroll
        for (int j = 0; j < 8; ++j) { const int c0 = 4 * F.lane + 256 * j;
            const f32x4 w = *(const f32x4*)(F.ln_w + c0), bb = *(const f32x4*)(F.ln_b + c0);
            zr[64 * j] = v[j] * rstd * w + bb; }
    }
}

struct Args { const void* in[11]; float* out; unsigned char* ws; int ph_lo, ph_hi, li, pad; };
__global__ void __launch_bounds__(NTHR, 2) hymba_fwd(Args args) {
    extern __shared__ __attribute__((aligned(16))) unsigned char lds[];
    Frame F;
    F.lds = (LAS unsigned char*)lds;
    F.MISC = (volatile LAS unsigned*)(F.lds + MISC_OFF);
    F.tid = threadIdx.x; F.lane = F.tid & 63; F.wave = __builtin_amdgcn_readfirstlane(F.tid >> 6);
    F.G = gridDim.x; { const int bx = blockIdx.x; F.vcu = (F.G % 8 == 0) ? (bx % 8) * (F.G / 8) + bx / 8 : bx; }
    unsigned char* ws = args.ws;
    F.ctl = (gu32*)(ws + WS_CTL);
    F.x = (const float*)args.in[0]; F.c = (const float*)args.in[1]; F.positions = (const int*)args.in[2]; F.w_ada = (const float*)args.in[3]; F.b_ada = (const float*)args.in[4];
    F.w_in = (const float*)args.in[5]; F.lb_logits = (const float*)args.in[6]; F.hg_norm_w = (const float*)args.in[7]; F.w_out = (const float*)args.in[8];
    F.ln_w = (const float*)args.in[9]; F.ln_b = (const float*)args.in[10]; F.out = args.out;
    F.LB = (float*)(ws + WS_LB); F.GATE = (float*)(ws + WS_GATE); F.LAM = (float*)(ws + WS_LAM); F.MODP = (float*)(ws + WS_MODP); F.ROPE = (float*)(ws + WS_ROPE);
    F.WIN = (bf16*)(ws + WS_WIN); F.WOUT = (bf16*)(ws + WS_WOUT); F.HB = (bf16*)(ws + WS_H); F.PROJ = (bf16*)(ws + WS_PROJ); F.RS = (bf16*)(ws + WS_RS); F.HS = (bf16*)(ws + WS_HS);
    for (int u = F.tid; u < (LDS_BYTES - LDSCTL_OFF) / 4; u += NTHR) ((LAS unsigned*)(F.lds + LDSCTL_OFF))[u] = 0u;
    __syncthreads();
    XcdBarrier bar; bar.bar = (unsigned*)(F.ctl + CW_BAR); bar.x = 0; bar.st = nullptr;
    if (N_LAUNCHES != NPHASE) bar = xcd_barrier_post((unsigned*)(F.ctl + CW_BAR), F.MISC + 8);
#define GRID_BAR() do { if (N_LAUNCHES != NPHASE) xcd_barrier(bar); } while (0)
    const int lo = args.ph_lo, hi = args.ph_hi;
#define IN(k) (lo <= (k) && (k) < hi)
#define BOTH(k) (IN(k) && IN((k) + 1))

    if (IN(0)) { p0_prologue(F); if (BOTH(0)) GRID_BAR(); }
    if (IN(1)) { p1_modulate(F); if (BOTH(1)) GRID_BAR(); }
    if (IN(2)) {
        pg8::Gemm g{F.HB, F.WIN, M, NIN, D}; pg8::StaticOrder S; S.init(M, NIN, F.G, (int)blockIdx.x);
        pg8::EpiProj E{F.PROJ, NIN};
        pg8::gemm_phase<pg8::EpiProj, pg8::StaticOrder, true, true>(F.lds + RING_OFF, g, S, E);
        if (BOTH(2)) GRID_BAR();
    }
    if (IN(3)) { p3_transform_naive(F); if (BOTH(3)) GRID_BAR(); }
    if (IN(4)) { p4_state_naive(F); if (BOTH(4)) GRID_BAR(); }
    if (IN(5)) { p5_output_naive(F); if (BOTH(5)) GRID_BAR(); }
    if (IN(6)) {
        pg8::Gemm g{F.HB, F.WOUT, M, D, D}; pg8::StaticOrder S; S.init(M, D, F.G, (int)blockIdx.x);
        pg8::EpiZ E{F.x, F.out, D, F.GATE, T, ALPHA};
        pg8::gemm_phase<pg8::EpiZ, pg8::StaticOrder, true, true>(F.lds + RING_OFF, g, S, E);
        if (BOTH(6)) GRID_BAR();
    }
    if (IN(7)) { p7_final_ln(F); }
#undef IN
#undef BOTH
}

extern "C" void kernel_launch(void* const* d_in, const int* in_sizes, int n_in, void* d_out, int out_size, void* d_ws, size_t ws_size, hipStream_t stream) {
    static int grid = 0;
    if (grid == 0) {
        if (n_in != 11 || in_sizes[0] != M * D || out_size != M * D || ws_size < WS_END) { fprintf(stderr, "kernel_launch: unexpected shapes: n_in %d in0 %d out %d ws %zu (need %zu)\n", n_in, n_in > 0 ? in_sizes[0] : -1, out_size, ws_size, (size_t)WS_END); grid = -1; return; }
        int dev = 0, cus = 0, per_cu = 0;
        if (hipGetDevice(&dev) != hipSuccess || hipDeviceGetAttribute(&cus, hipDeviceAttributeMultiprocessorCount, dev) != hipSuccess) { fprintf(stderr, "kernel_launch: device query failed\n"); grid = -1; return; }
        if (hipFuncSetAttribute((const void*)hymba_fwd, hipFuncAttributeMaxDynamicSharedMemorySize, LDS_BYTES) != hipSuccess) { fprintf(stderr, "kernel_launch: hipFuncSetAttribute failed\n"); grid = -1; return; }
        if (hipOccupancyMaxActiveBlocksPerMultiprocessor(&per_cu, (const void*)hymba_fwd, NTHR, LDS_BYTES) != hipSuccess || per_cu < 1) { fprintf(stderr, "kernel_launch: occupancy query says %d workgroups per CU\n", per_cu); }
        (void)hipGetLastError();
        grid = cus;
    }
    if (grid < 0) return;
    if (hipMemsetAsync((char*)d_ws + WS_CTL, 0, CTL_ZERO_BYTES, stream) != hipSuccess) { fprintf(stderr, "kernel_launch: memset failed\n"); return; }
    Args a{};
    for (int i = 0; i < 11; ++i) a.in[i] = d_in[i];
    a.out = (float*)d_out; a.ws = (unsigned char*)d_ws;
    for (int li = 0; li < N_LAUNCHES; ++li) {
        a.ph_lo = (N_LAUNCHES == NPHASE) ? li : 0; a.ph_hi = (N_LAUNCHES == NPHASE) ? li + 1 : NPHASE; a.li = li;
        hipLaunchKernelGGL(hymba_fwd, dim3(grid), dim3(NTHR), LDS_BYTES, stream, a);
        const hipError_t le = hipPeekAtLastError();
        if (le != hipSuccess) { fprintf(stderr, "kernel_launch: launch %d failed: %s\n", li, hipGetErrorName(le)); break; }
    }
}
```

```cpp
#include <hip/hip_runtime.h>
#include <cstdio>
#include <cstdint>
namespace pg8 {
#define PG8_LAS __attribute__((address_space(3)))
typedef unsigned short bf16_t;
typedef short bf16x8 __attribute__((ext_vector_type(8)));
typedef float f32x4 __attribute__((ext_vector_type(4)));
typedef unsigned u32x4 __attribute__((ext_vector_type(4)));
constexpr int BM = 256, BK = 64, HALF = 128, HTB = HALF * BK * 2  , STAGE_BYTES = 8 * HTB, NXCD = 8, WGM = 8;

__host__ __device__ __forceinline__ int lds_byte(int r, int c) { const int st = (r >> 4) * 2 + (c >> 5), rr = r & 15, cc = c & 31, ob = rr * 64 + cc * 2; return st * 1024 + (ob ^ (((ob >> 9) & 1) << 5)); }
__host__ __device__ __forceinline__ void stage_rc(int b, int& R, int& C) { const int st = b / 1024, sb = b % 1024, swz = sb ^ (((sb >> 9) & 1) << 5); R = (st >> 1) * 16 + swz / 64; C = (st & 1) * 32 + (swz % 64) / 2; }
__host__ __device__ __forceinline__ int perm32(int rho) { const int n = rho >> 4, i = rho & 15; return 8 * (i >> 2) + 4 * n + (i & 3); }

struct Unit { int pm, pn; };
struct Gemm { const bf16_t* A; const bf16_t* Bt; int M, N, K; };

struct StaticOrder {
    int nM, nN, nwg, G, c;
    __host__ __device__ void init(int M, int N, int G_, int c_) { nM = M / BM; nN = N / BM; nwg = nM * nN; G = G_; c = c_; }
    __host__ __device__ bool next(int i, Unit& u) const {
        const long L = (long)i * G + c; if (L >= nwg) return false;
        int wgid = (int)L; { const int q = nwg / NXCD, r = nwg % NXCD, xcd = wgid % NXCD, off = wgid / NXCD; wgid = (xcd < r ? xcd * (q + 1) : r * (q + 1) + (xcd - r) * q) + off; }
        const int nig = WGM * nN, gid = wgid / nig, fm = gid * WGM, gsz = (nM - fm) < WGM ? (nM - fm) : WGM;
        u.pm = fm + ((wgid % nig) % gsz); u.pn = (wgid % nig) / gsz; return true;
    }
    __device__ __forceinline__ void a_ready(const Unit&) const {}
    __device__ __forceinline__ void done(const Unit&) const {}
};

__device__ __forceinline__ unsigned cvt_pk_bf16(float lo, float hi) { unsigned r; asm volatile("v_cvt_pk_bf16_f32 %0, %1, %2" : "=v"(r) : "v"(lo), "v"(hi)); return r; }
struct EpiProj {
    static constexpr bool PERM = true, AFTER_DRAIN = false;
    bf16_t* O; int ldc;
    __device__ __forceinline__ void operator()(const f32x4 (&acc)[2][2][4][2], const Unit& u, int wr, int wc, int fr, int fq) const {
        const int row0 = u.pm * BM + wr * 64 + fr, col0 = u.pn * BM + wc * 32 + 8 * fq;
#pragma unroll
        for (int ai = 0; ai < 2; ++ai)
#pragma unroll
            for (int m = 0; m < 4; ++m) { bf16_t* rowp = O + (size_t)(row0 + ai * HALF + m * 16) * ldc + col0;
#pragma unroll
                for (int bj = 0; bj < 2; ++bj) { const f32x4 v0 = acc[ai][bj][m][0], v1 = acc[ai][bj][m][1];
                    u32x4 w; w.x = cvt_pk_bf16(v0[0], v0[1]); w.y = cvt_pk_bf16(v0[2], v0[3]); w.z = cvt_pk_bf16(v1[0], v1[1]); w.w = cvt_pk_bf16(v1[2], v1[3]);
                    *(u32x4*)(rowp + bj * HALF) = w; } }
    }
};
struct EpiZ {
    static constexpr bool PERM = false, AFTER_DRAIN = false;
    const float* X; float* Z; int ldc; const float* gate; int rows_per_batch; float alpha;
    __device__ __forceinline__ void operator()(const f32x4 (&acc)[2][2][4][2], const Unit& u, int wr, int wc, int fr, int fq) const {
        const int row0 = u.pm * BM + wr * 64 + fr, col0 = u.pn * BM + wc * 32 + 4 * fq;
        const float* g = gate + (size_t)((u.pm * BM) / rows_per_batch) * ldc + col0;
        f32x4 gv[2][2];
#pragma unroll
        for (int bj = 0; bj < 2; ++bj)
#pragma unroll
            for (int n = 0; n < 2; ++n) gv[bj][n] = *(const f32x4*)(g + bj * HALF + n * 16);
#pragma unroll
        for (int ai = 0; ai < 2; ++ai)
#pragma unroll
            for (int m = 0; m < 4; ++m) { const size_t off = (size_t)(row0 + ai * HALF + m * 16) * ldc + col0;
#pragma unroll
                for (int bj = 0; bj < 2; ++bj)
#pragma unroll
                    for (int n = 0; n < 2; ++n) { const f32x4 xv = *(const f32x4*)(X + off + bj * HALF + n * 16);
                        *(f32x4*)(Z + off + bj * HALF + n * 16) = xv * alpha + gv[bj][n] * acc[ai][bj][m][n]; }
                asm volatile("" ::: "memory"); }
    }
};
template <class Epi, class Sched, bool ALIGN_EPI = false, bool SP2 = false>
__device__ __forceinline__ void gemm_phase(PG8_LAS unsigned char* lds, const Gemm g, const Sched& S, const Epi& E) {
    const int tid = threadIdx.x, wid = __builtin_amdgcn_readfirstlane(tid >> 6), lane = tid & 63, wr = wid >> 2, wc = wid & 3, fr = lane & 15, fq = lane >> 4;
    const int K = g.K, nt = K / BK;
    unsigned voffA[2], voffB[2];
#pragma unroll
    for (int i = 0; i < 2; ++i) { int R, C; stage_rc(tid * 16 + i * 8192, R, C); const int Rb = Epi::PERM ? ((R & ~31) + perm32(R & 31)) : R;
        voffA[i] = (unsigned)(R * K + C) * 2u; voffB[i] = (unsigned)(Rb * K + C) * 2u; }
    const size_t kstep = (size_t)(BK * 2);
    const size_t hstep = (size_t)HALF * K * 2;
    const size_t tstep = 2 * hstep;
    const unsigned ldsw = (unsigned)wid * 1024u;
    const int aoff = lds_byte(wr * 64 + fr, fq * 8), boff = lds_byte(wc * 32 + fr, fq * 8);
#define PG8_SA(b, h) (((b) * 2 + (h)) * HTB)
#define PG8_SB(b, h) ((4 + (b) * 2 + (h)) * HTB)
#define PG8_STAGE(bufoff, gbase, voff) do { _Pragma("unroll") for (int _i = 0; _i < 2; ++_i) \
        __builtin_amdgcn_global_load_lds((const unsigned*)((const char*)(gbase) + (voff)[_i]), (PG8_LAS unsigned*)(lds + (bufoff) + ldsw + _i * 8192), 16, 0, 0); } while (0)
#define PG8_LDA(dst, b, h) do { _Pragma("unroll") for (int m = 0; m < 4; ++m) _Pragma("unroll") for (int k = 0; k < 2; ++k) dst[m][k] = *(const PG8_LAS bf16x8*)(lds + PG8_SA(b, h) + aoff + m * 2048 + k * 1024); } while (0)
#define PG8_LDB(dst, b, h) do { _Pragma("unroll") for (int n = 0; n < 2; ++n) _Pragma("unroll") for (int k = 0; k < 2; ++k) dst[n][k] = *(const PG8_LAS bf16x8*)(lds + PG8_SB(b, h) + boff + n * 2048 + k * 1024); } while (0)
#define PG8_MMA(ai, bj, At, Bt) do { __builtin_amdgcn_s_setprio(1); _Pragma("unroll") for (int m = 0; m < 4; ++m) _Pragma("unroll") for (int n = 0; n < 2; ++n) _Pragma("unroll") for (int k = 0; k < 2; ++k) \
        acc[ai][bj][m][n] = __builtin_amdgcn_mfma_f32_16x16x32_bf16(Bt[n][k], At[m][k], acc[ai][bj][m][n], 0, 0, 0); __builtin_amdgcn_s_setprio(0); } while (0)
#define PG8_WAIT_V(n) asm volatile("s_waitcnt vmcnt(" #n ")" ::: "memory")
#define PG8_WAIT_L(n) asm volatile("s_waitcnt lgkmcnt(" #n ")" ::: "memory")
#define PG8_BAR __builtin_amdgcn_s_barrier()
#define PG8_SCHED __builtin_amdgcn_sched_barrier(0)
    Unit cur, nxt; int ui = 0;
    if (!S.next(0, cur)) return;
    f32x4 acc[2][2][4][2];
#pragma unroll
    for (int a = 0; a < 2; ++a)
#pragma unroll
        for (int b = 0; b < 2; ++b)
#pragma unroll
            for (int m = 0; m < 4; ++m)
#pragma unroll
                for (int n = 0; n < 2; ++n) acc[a][b][m][n] = (f32x4){0.f, 0.f, 0.f, 0.f};
    bf16x8 At[4][2], B0[2][2], B1[2][2];
    const char* cA = (const char*)g.A + (size_t)cur.pm * tstep; const char* cB = (const char*)g.Bt + (size_t)cur.pn * tstep;
    S.a_ready(cur);
    if constexpr (SP2) {
        PG8_STAGE(PG8_SB(0, 0), cB, voffB); PG8_STAGE(PG8_SB(0, 1), cB + hstep, voffB); PG8_STAGE(PG8_SA(0, 0), cA, voffA); PG8_STAGE(PG8_SA(0, 1), cA + hstep, voffA);
        if (wr == 1) PG8_BAR;
        PG8_WAIT_V(2); PG8_BAR;
        PG8_STAGE(PG8_SB(1, 0), cB + kstep, voffB); PG8_STAGE(PG8_SA(1, 0), cA + kstep, voffA); PG8_STAGE(PG8_SB(1, 1), cB + hstep + kstep, voffB);
        PG8_WAIT_V(6); PG8_BAR;
    } else {
        PG8_STAGE(PG8_SB(0, 0), cB, voffB); PG8_STAGE(PG8_SA(0, 0), cA, voffA); PG8_STAGE(PG8_SB(0, 1), cB + hstep, voffB); PG8_STAGE(PG8_SA(0, 1), cA + hstep, voffA);
        if (wr == 1) PG8_BAR;
        PG8_WAIT_V(4); PG8_BAR;
        PG8_STAGE(PG8_SB(1, 0), cB + kstep, voffB); PG8_STAGE(PG8_SA(1, 0), cA + kstep, voffA); PG8_STAGE(PG8_SB(1, 1), cB + hstep + kstep, voffB);
        PG8_WAIT_V(6); PG8_BAR;
    }
    for (;;) {
        const bool has_next = S.next(ui + 1, nxt);
        const char* nA = has_next ? (const char*)g.A + (size_t)nxt.pm * tstep : cA; const char* nB = has_next ? (const char*)g.Bt + (size_t)nxt.pn * tstep : cB;
        for (int t = 0; t < nt; t += 2) {
            const bool last = (t == nt - 2);
            const char* a1 = cA + (size_t)(t + 1) * kstep;
            const char* a2 = last ? nA : cA + (size_t)(t + 2) * kstep; const char* b2 = last ? nB : cB + (size_t)(t + 2) * kstep;
            const char* a3 = a2 + kstep; const char* b3 = b2 + kstep;
            if (last && has_next) S.a_ready(nxt);
            if constexpr (SP2) {
            PG8_LDB(B0, 0, 0); PG8_LDB(B1, 0, 1); PG8_SCHED; PG8_LDA(At, 0, 0); PG8_STAGE(PG8_SA(1, 1), a1 + hstep, voffA);
            PG8_WAIT_V(8); PG8_WAIT_L(0); PG8_BAR; PG8_MMA(0, 0, At, B0); PG8_MMA(0, 1, At, B1); PG8_BAR; PG8_SCHED;
            PG8_LDA(At, 0, 1); PG8_STAGE(PG8_SB(0, 0), b2, voffB); PG8_STAGE(PG8_SB(0, 1), b2 + hstep, voffB); PG8_STAGE(PG8_SA(0, 0), a2, voffA);
            PG8_WAIT_V(8); PG8_WAIT_L(0); PG8_BAR; PG8_MMA(1, 0, At, B0); PG8_MMA(1, 1, At, B1); PG8_BAR; PG8_SCHED;
            PG8_LDB(B0, 1, 0); PG8_LDB(B1, 1, 1); PG8_SCHED; PG8_LDA(At, 1, 0); PG8_STAGE(PG8_SA(0, 1), a2 + hstep, voffA);
            PG8_WAIT_V(8); PG8_WAIT_L(0); PG8_BAR; PG8_MMA(0, 0, At, B0); PG8_MMA(0, 1, At, B1); PG8_BAR; PG8_SCHED;
            PG8_LDA(At, 1, 1); PG8_STAGE(PG8_SB(1, 0), b3, voffB); PG8_STAGE(PG8_SB(1, 1), b3 + hstep, voffB); PG8_STAGE(PG8_SA(1, 0), a3, voffA);
            PG8_WAIT_V(8); PG8_WAIT_L(0); PG8_BAR; PG8_MMA(1, 0, At, B0); PG8_MMA(1, 1, At, B1); PG8_BAR; PG8_SCHED;
            } else {
            PG8_LDB(B0, 0, 0); PG8_SCHED; PG8_LDA(At, 0, 0); PG8_STAGE(PG8_SA(1, 1), a1 + hstep, voffA);
            PG8_WAIT_L(8); PG8_BAR; PG8_WAIT_L(0); PG8_MMA(0, 0, At, B0); PG8_BAR; PG8_SCHED;
            PG8_LDB(B1, 0, 1); PG8_STAGE(PG8_SB(0, 0), b2, voffB);
            PG8_BAR; PG8_WAIT_L(0); PG8_MMA(0, 1, At, B1); PG8_BAR;
            PG8_LDA(At, 0, 1); PG8_STAGE(PG8_SA(0, 0), a2, voffA);
            PG8_BAR; PG8_WAIT_L(0); PG8_MMA(1, 0, At, B0); PG8_BAR; PG8_SCHED;
            PG8_STAGE(PG8_SB(0, 1), b2 + hstep, voffB);
            PG8_WAIT_V(6); PG8_BAR; PG8_MMA(1, 1, At, B1); PG8_BAR;
            PG8_LDB(B0, 1, 0); PG8_SCHED; PG8_LDA(At, 1, 0); PG8_STAGE(PG8_SA(0, 1), a2 + hstep, voffA);
            PG8_WAIT_L(8); PG8_BAR; PG8_WAIT_L(0); PG8_MMA(0, 0, At, B0); PG8_BAR; PG8_SCHED;
            PG8_LDB(B1, 1, 1); PG8_STAGE(PG8_SB(1, 0), b3, voffB);
            PG8_BAR; PG8_WAIT_L(0); PG8_MMA(0, 1, At, B1); PG8_BAR;
            PG8_LDA(At, 1, 1); PG8_STAGE(PG8_SA(1, 0), a3, voffA);
            PG8_BAR; PG8_WAIT_L(0); PG8_MMA(1, 0, At, B0); PG8_BAR; PG8_SCHED;
            PG8_STAGE(PG8_SB(1, 1), b3 + hstep, voffB);
            PG8_WAIT_V(6); PG8_BAR; PG8_MMA(1, 1, At, B1); PG8_BAR;
            }
        }
        if constexpr (ALIGN_EPI) { if (wr == 0) PG8_BAR; }
        if constexpr (!Epi::AFTER_DRAIN) { E(acc, cur, wr, wc, fr, fq); S.done(cur); }
        if (!has_next) break;
#pragma unroll
        for (int a = 0; a < 2; ++a)
#pragma unroll
            for (int b = 0; b < 2; ++b)
#pragma unroll
                for (int m = 0; m < 4; ++m)
#pragma unroll
                    for (int n = 0; n < 2; ++n) acc[a][b][m][n] = (f32x4){0.f, 0.f, 0.f, 0.f};
        cur = nxt; cA = nA; cB = nB; ++ui;
        if constexpr (ALIGN_EPI) { if (wr == 1) PG8_BAR; }
    }
    PG8_WAIT_V(0);
    if constexpr (!ALIGN_EPI) { if (wr == 0) PG8_BAR; }
    PG8_BAR;
    if constexpr (Epi::AFTER_DRAIN) { E.fused(acc, cur, wr, wc, fr, fq, lds, wid, lane); S.done(cur); }
#undef PG8_SA
#undef PG8_SB
#undef PG8_STAGE
#undef PG8_LDA
#undef PG8_LDB
#undef PG8_MMA
#undef PG8_WAIT_V
#undef PG8_WAIT_L
#undef PG8_BAR
#undef PG8_SCHED
}
}

constexpr int NWAVES = 8, NTHR = NWAVES * 64;
constexpr int BATCH = 8, T = 2048, D = 2048, M = BATCH * T, NIN = 7168, NMOD = 3 * D;
constexpr int RH = 4, RDK = 128, RDV = 256, RC = 128, RN = T / RC;
constexpr int HH = 8, HDK = 128, HDV = 128, HC = 64, HN = T / HC;
constexpr int C_RQ = 0, C_RK = 512, C_RV = 1024, C_RG = 2048, C_HQ = 3072, C_HF = 4096, C_HI = 5120, C_HG = 6144;
constexpr float EPS = 1e-6f;
constexpr float ALPHA = 1.189207115002721f;
constexpr int MOD_KS = 16;
#ifndef MK_N_LAUNCHES
#define MK_N_LAUNCHES 1
#endif
constexpr int NPHASE = 8;
constexpr int N_LAUNCHES = MK_N_LAUNCHES;

constexpr size_t MiB = 1u << 20;
constexpr size_t WS_CTL = 0, CTL_ZERO_BYTES = 64 * 1024;
constexpr size_t WS_LB = 1 * MiB;
constexpr size_t WS_GATE = WS_LB + 64 * 1024;
constexpr size_t WS_LAM = 2 * MiB;
constexpr size_t WS_MODP = 3 * MiB;
constexpr size_t WS_ROPE = 6 * MiB;
constexpr size_t WS_WIN = 14 * MiB;
constexpr size_t WS_WOUT = 43 * MiB;
constexpr size_t WS_H = 52 * MiB;
constexpr size_t WS_PROJ = 116 * MiB;
constexpr size_t WS_RS = 340 * MiB;
constexpr size_t WS_HS = 372 * MiB;
constexpr size_t WS_END = 436 * MiB;
static_assert(WS_WIN + (size_t)NIN * D * 2 <= WS_WOUT && WS_WOUT + (size_t)D * D * 2 <= WS_H && WS_H + (size_t)M * D * 2 <= WS_PROJ && WS_PROJ + (size_t)M * NIN * 2 <= WS_RS &&
              WS_RS + (size_t)BATCH * RN * RH * RDV * RDK * 2 <= WS_HS && WS_HS + (size_t)BATCH * HN * HH * HDV * HDK * 2 <= WS_END && WS_MODP + (size_t)MOD_KS * BATCH * NMOD * 4 <= WS_ROPE &&
              WS_ROPE + (size_t)BATCH * T * 128 * 4 <= WS_WIN, "d_ws map");
constexpr int CW_BAR = 1024;

constexpr int RING_OFF = 0, RING_BYTES = 131072;
constexpr int LDSCTL_OFF = RING_BYTES, MISC_OFF = LDSCTL_OFF + 320;
constexpr int LDS_BYTES = 147456;

#define GAS __attribute__((address_space(1)))
#define LAS __attribute__((address_space(3)))
typedef unsigned short bf16;
typedef unsigned v4u __attribute__((ext_vector_type(4)));
typedef unsigned v2u __attribute__((ext_vector_type(2)));
typedef float f32x4 __attribute__((ext_vector_type(4)));
typedef GAS unsigned gu32;
#define RLX_AGENT __ATOMIC_RELAXED, __HIP_MEMORY_SCOPE_AGENT
#define LDS_WAIT() asm volatile("s_waitcnt lgkmcnt(0)" ::: "memory")
#define VM_WAIT() asm volatile("s_waitcnt vmcnt(0)" ::: "memory")
__device__ __forceinline__ unsigned f2bf(float f) { unsigned u = __builtin_bit_cast(unsigned, f); return (u + 0x7fffu + ((u >> 16) & 1u)) >> 16; }
__device__ __forceinline__ unsigned pk2(float lo, float hi) { return f2bf(lo) | (f2bf(hi) << 16); }
__device__ __forceinline__ float bf2f(unsigned short b) { return __builtin_bit_cast(float, (unsigned)b << 16); }
__device__ __forceinline__ float bflo(unsigned w) { return __builtin_bit_cast(float, w << 16); }
__device__ __forceinline__ float bfhi(unsigned w) { return __builtin_bit_cast(float, w & 0xffff0000u); }
__device__ __forceinline__ float wave_sum(float v) {
#pragma unroll
    for (int o = 1; o < 64; o <<= 1) v += __shfl_xor(v, o);
    return v;
}
__device__ __forceinline__ float sigmoidf_(float x) { return 1.0f / (1.0f + __expf(-x)); }
__device__ __forceinline__ float siluf_(float x) { return x / (1.0f + __expf(-x)); }
__device__ __forceinline__ float ret_log2_gamma(int h) {
    const float e = (float)(5.0 + 7.0 * (double)h / 3.0);
    return log1pf(-exp2f(-e)) * 1.4426950408889634f;
}
#define XB_TMO      128
#define XB_XCNT(j)  (256  + 64 * (j))
#define XB_XSUB(j)  (1280 + 64 * (j))
#define XB_XGEN(j)  (2304 + 64 * (j))
#define XB_TOP      3328
#define XB_TOPGEN   3392
#define XCD_BAR_WORDS 3456
#define XB_SPIN_CAP (1u << 18)

__device__ __forceinline__ unsigned xb_ld(unsigned* p)              { return __hip_atomic_load(p, __ATOMIC_RELAXED, __HIP_MEMORY_SCOPE_AGENT); }
__device__ __forceinline__ unsigned xb_add(unsigned* p, unsigned v) { return __hip_atomic_fetch_add(p, v, __ATOMIC_RELAXED, __HIP_MEMORY_SCOPE_AGENT); }
__device__ __forceinline__ unsigned xb_xcc_id() { return (unsigned)__builtin_amdgcn_s_getreg((3 << 11) | 20) & 0xFu; }
#define XB_SPIN(cond, bar) do { unsigned _sp = 0; while (cond) { __builtin_amdgcn_s_sleep(1); \
    if ((++_sp & 255u) == 0u) { if (xb_ld(&(bar)[XB_TMO])) break; if (_sp > XB_SPIN_CAP) { atomicAdd(&(bar)[XB_TMO], 1u); break; } } } } while (0)

struct XcdBarrier {
    unsigned* bar; unsigned x;
    volatile LAS unsigned* st;
};

__device__ __forceinline__ XcdBarrier xcd_barrier_post(unsigned* bar, volatile LAS unsigned* st) {
    XcdBarrier b; b.bar = bar; b.x = xb_xcc_id(); b.st = st;
    if (threadIdx.x == 0) (void)xb_add(&bar[XB_XCNT(b.x)], 1u);
    return b;
}
__device__ __forceinline__ void xcd_barrier_complete(unsigned* bar, unsigned x, unsigned& nloc, unsigned& nx) {
    const unsigned G = gridDim.x * gridDim.y * gridDim.z;
    unsigned sum, cnt, mine, sp = 0u;
    for (;;) {
        sum = 0u; cnt = 0u; mine = 0u;
#pragma unroll
        for (unsigned j = 0; j < 16; ++j) { const unsigned c = xb_ld(&bar[XB_XCNT(j)]); sum += c; cnt += (c > 0u) ? 1u : 0u; mine = (j == x) ? c : mine; }
        if (sum == G) break;
        __builtin_amdgcn_s_sleep(1);
        if ((++sp & 255u) == 0u) { if (xb_ld(&bar[XB_TMO])) break; if (sp > XB_SPIN_CAP) { atomicAdd(&bar[XB_TMO], 1u); break; } }
    }
    nloc = mine > 0u ? mine : 1u; nx = cnt > 0u ? cnt : 1u;
}

__device__ __forceinline__ void xcd_barrier(const XcdBarrier& b) {
    asm volatile("s_waitcnt vmcnt(0)" ::: "memory");
    __syncthreads();
    if (threadIdx.x == 0) {
        unsigned* bar = b.bar;
        __builtin_amdgcn_s_waitcnt(0);
        unsigned nloc = b.st[0], nx = b.st[1];
        if (nloc == 0u) { xcd_barrier_complete(bar, b.x, nloc, nx); b.st[0] = nloc; b.st[1] = nx; }
        const unsigned old = xb_add(&bar[XB_XSUB(b.x)], 1u);
        const unsigned gen = old / nloc;
        if (old + 1u == (gen + 1u) * nloc) {
            __builtin_amdgcn_fence(__ATOMIC_RELEASE, "agent");
            asm volatile("s_waitcnt vmcnt(0)" ::: "memory");
            const unsigned og = xb_add(&bar[XB_TOP], 1u);
            const unsigned tg = og / nx;
            if (og + 1u == (tg + 1u) * nx) xb_add(&bar[XB_TOPGEN], 1u);
            else XB_SPIN(xb_ld(&bar[XB_TOPGEN]) == tg, bar);
            __builtin_amdgcn_fence(__ATOMIC_ACQUIRE, "agent");
            xb_add(&bar[XB_XGEN(b.x)], 1u);
            asm volatile("s_waitcnt vmcnt(0)" ::: "memory");
        } else {
            XB_SPIN(xb_ld(&bar[XB_XGEN(b.x)]) == gen, bar);
            __builtin_amdgcn_fence(__ATOMIC_ACQUIRE, "agent");
            asm volatile("s_waitcnt vmcnt(0)" ::: "memory");
        }
    }
    __syncthreads();
}

struct Frame {
    LAS unsigned char* lds;
    volatile LAS unsigned* MISC;
    gu32* ctl;
    int tid, lane, wave, vcu, G;
    const float *x, *c, *w_ada, *b_ada, *w_in, *lb_logits, *hg_norm_w, *w_out, *ln_w, *ln_b;
    const int* positions;
    float* out;
    float *LB, *GATE, *LAM, *MODP, *ROPE;
    bf16 *WIN, *WOUT, *HB, *PROJ, *RS, *HS;
};

__device__ __forceinline__ int win_dst_row(int n) { return n; }
__device__ __forceinline__ float win_col_scale(int n) { return n < C_RK ? 0.08838834764831845f : 1.0f; }

template <bool IS_WIN>
__device__ __forceinline__ void p0_transpose_item(const float* W, int K, int N, bf16* WT, LAS float* scr, int item, int lane) {
    const int nblk = N / 32, kb = item / nblk, nb = item % nblk, k0 = 64 * kb, n0 = 32 * nb;
#pragma unroll 8
    for (int i = 0; i < 32; ++i) { const int kk = 2 * i + (lane >> 5); scr[kk * 33 + (lane & 31)] = W[(size_t)(k0 + kk) * N + n0 + (lane & 31)]; }
    LDS_WAIT(); asm volatile("" ::: "memory");
    const int c = lane & 7;
#pragma unroll
    for (int j = 0; j < 4; ++j) { const int n = (lane >> 3) + 8 * j; const LAS float* s = scr + (8 * c) * 33 + n;
        const float sc = IS_WIN ? win_col_scale(n0 + n) : 1.0f; const int drow = IS_WIN ? win_dst_row(n0 + n) : (n0 + n);
        v4u o; o.x = pk2(s[0 * 33] * sc, s[1 * 33] * sc); o.y = pk2(s[2 * 33] * sc, s[3 * 33] * sc); o.z = pk2(s[4 * 33] * sc, s[5 * 33] * sc); o.w = pk2(s[6 * 33] * sc, s[7 * 33] * sc);
        *(GAS v4u*)(WT + (size_t)drow * K + k0 + 8 * c) = o; }
    LDS_WAIT(); asm volatile("" ::: "memory");
}

__device__ __forceinline__ void p0_prologue(Frame& F) {
    {
        LAS float* sc = (LAS float*)(F.lds + RING_OFF);
        constexpr int KS = D / MOD_KS, NCB = NMOD / NTHR;
        for (int it = blockIdx.x; it < MOD_KS * NCB; it += F.G) {
            const int s = it / NCB, cb = it % NCB, k0 = s * KS, n = cb * NTHR + F.tid;
            __syncthreads();
            for (int i = F.tid; i < BATCH * KS; i += NTHR) { const int b = i / KS, k = i % KS; sc[i] = siluf_(F.c[(size_t)b * D + k0 + k]); }
            __syncthreads();
            float acc[BATCH];
#pragma unroll
            for (int b = 0; b < BATCH; ++b) acc[b] = (s == 0) ? F.b_ada[n] : 0.f;
#pragma unroll 4
            for (int k = 0; k < KS; ++k) { const float w = F.w_ada[(size_t)(k0 + k) * NMOD + n];
#pragma unroll
                for (int b = 0; b < BATCH; ++b) acc[b] += sc[b * KS + k] * w; }
#pragma unroll
            for (int b = 0; b < BATCH; ++b) F.MODP[((size_t)s * BATCH + b) * NMOD + n] = acc[b];
        }
        __syncthreads();
    }
    {
        LAS float* scr = (LAS float*)(F.lds + RING_OFF + F.wave * 16384);
        const int gw = F.vcu * NWAVES + F.wave, NGW = F.G * NWAVES;
        constexpr int I_IN = (D / 64) * (NIN / 32), I_OUT = (D / 64) * (D / 32);
        for (int it = gw; it < I_IN + I_OUT; it += NGW) {
            if (it < I_IN) p0_transpose_item<true>(F.w_in, D, NIN, F.WIN, scr, it, F.lane);
            else p0_transpose_item<false>(F.w_out, D, D, F.WOUT, scr, it - I_IN, F.lane);
        }
    }
    {
        const int gt = blockIdx.x * NTHR + F.tid, NGT = F.G * NTHR;
        for (int idx = gt; idx < BATCH * T * 64; idx += NGT) {
            const int i = idx & 63, bt = idx >> 6;
            const float freq = (float)pow(10000.0, -(double)i / 64.0);
            const float ang = (float)F.positions[bt] * freq;
            double sn, cs; sincos((double)ang, &sn, &cs);
            F.ROPE[(size_t)bt * 128 + i] = (float)cs; F.ROPE[(size_t)bt * 128 + 64 + i] = (float)sn;
        }
        for (int idx = gt; idx < HH * HDK; idx += NGT) { const float l0 = F.lb_logits[idx], l1 = F.lb_logits[HH * HDK + idx]; const float mx = fmaxf(l0, l1);
            const float e0 = expf(l0 - mx), e1 = expf(l1 - mx); F.LB[idx] = e0 / (e0 + e1); }
    }
}

__device__ __forceinline__ void p1_modulate(Frame& F) {
    LAS float* sh = (LAS float*)(F.lds + RING_OFF);
    constexpr int ROWS_WG = 64;
    for (int blk = blockIdx.x; blk < M / ROWS_WG; blk += F.G) {
        const int b = (blk * ROWS_WG) / T;
        __syncthreads();
        for (int i = F.tid; i < 2 * D; i += NTHR) { float s = 0.f;
#pragma unroll
            for (int ks = 0; ks < MOD_KS; ++ks) s += F.MODP[((size_t)ks * BATCH + b) * NMOD + i];
            sh[i] = s; }
        if ((blk * ROWS_WG) % T == 0) {
            for (int i = F.tid; i < D; i += NTHR) { float s = 0.f;
#pragma unroll
                for (int ks = 0; ks < MOD_KS; ++ks) s += F.MODP[((size_t)ks * BATCH + b) * NMOD + 2 * D + i];
                F.GATE[(size_t)b * D + i] = s; }
        }
        __syncthreads();
        for (int r = F.wave; r < ROWS_WG; r += NWAVES) {
            const int row = blk * ROWS_WG + r;
            const GAS f32x4* xr = (const GAS f32x4*)(F.x + (size_t)row * D) + F.lane;
            f32x4 v[8]; float s = 0.f;
#pragma unroll
            for (int j = 0; j < 8; ++j) { v[j] = xr[64 * j]; s += (v[j].x + v[j].y) + (v[j].z + v[j].w); }
            const float mean = wave_sum(s) * (1.f / D); float s2 = 0.f;
#pragma unroll
            for (int j = 0; j < 8; ++j) { v[j] = v[j] - mean; s2 += (v[j].x * v[j].x + v[j].y * v[j].y) + (v[j].z * v[j].z + v[j].w * v[j].w); }
            const float rstd = 1.f / sqrtf(wave_sum(s2) * (1.f / D) + EPS);
            GAS v2u* o8 = (GAS v2u*)(F.HB + (size_t)row * D) + F.lane;
#pragma unroll
            for (int j = 0; j < 8; ++j) { const int c0 = 4 * F.lane + 256 * j;
                const f32x4 sf = *(const LAS f32x4*)(sh + c0), sc = *(const LAS f32x4*)(sh + D + c0);
                const f32x4 h = v[j] * rstd * (sc + 1.0f) + sf;
                v2u w; w.x = pk2(h.x, h.y); w.y = pk2(h.z, h.w); o8[64 * j] = w; }
        }
    }
    __syncthreads();
}

__device__ __forceinline__ void p3_transform_naive(Frame& F) {
    const long gt = (long)blockIdx.x * NTHR + F.tid, NGT = (long)F.G * NTHR;
    for (long idx = gt; idx < (long)M * 512; idx += NGT) {
        const int i = idx & 63, head = (idx >> 6) & 3, which = (idx >> 8) & 1; const int row = (int)(idx >> 9);
        bf16* p = F.PROJ + (size_t)row * NIN + (which ? C_RK : C_RQ) + head * RDK + i;
        const float x1 = bf2f(p[0]), x2 = bf2f(p[64]);
        const float cs = F.ROPE[(size_t)row * 128 + i], sn = F.ROPE[(size_t)row * 128 + 64 + i];
        const int tl = row % RC;
        const float lg = ret_log2_gamma(head);
        const float sc = exp2f((which ? -1.f : 1.f) * (float)(tl + 1) * lg);
        p[0] = (bf16)f2bf((x1 * cs - x2 * sn) * sc); p[64] = (bf16)f2bf((x1 * sn + x2 * cs) * sc);
    }
    for (long idx = gt; idx < (long)M * 2048; idx += NGT) {
        const int cc = idx & 2047; const int row = (int)(idx >> 11);
        bf16* p = F.PROJ + (size_t)row * NIN + (cc < 1024 ? C_RG + cc : C_HG + cc - 1024);
        p[0] = (bf16)f2bf(siluf_(bf2f(p[0])));
    }
    for (long idx = gt; idx < (long)BATCH * HN * HH * HDK; idx += NGT) {
        const int d = idx & 127, h = (idx >> 7) & 7, n = (idx >> 10) & 31, b = (int)(idx >> 15);
        const float lb = F.LB[h * HDK + d];
        float bs = 0.f;
        for (int s = 0; s < HC; ++s) {
            const size_t row = (size_t)b * T + n * HC + s;
            bf16* pq = F.PROJ + row * NIN + C_HQ + h * HDK + d; bf16* pf = F.PROJ + row * NIN + C_HF + h * HDK + d;
            const float q = bf2f(pq[0]), fp = bf2f(pf[0]);
            const float sg = 1.0f / (1.0f + expf(-fp)), sgn = 1.0f / (1.0f + expf(fp));
            const float f = lb + (1.0f - lb) * sg;
            bs += logf(f);
            pq[0] = (bf16)f2bf(q * expf(bs)); pf[0] = (bf16)f2bf((1.0f - lb) * sgn * expf(-bs));
        }
        F.LAM[idx] = expf(bs);
    }
}

__device__ __forceinline__ void p4_state_naive(Frame& F) {
    const long gt = (long)blockIdx.x * NTHR + F.tid, NGT = (long)F.G * NTHR;
    for (long idx = gt; idx < (long)BATCH * RH * RDV * RDK; idx += NGT) {
        const int d = idx & 127, e = (idx >> 7) & 255, h = (idx >> 15) & 3, b = (int)(idx >> 17);
        const float cd = exp2f((float)RC * ret_log2_gamma(h));
        float S = 0.f;
        for (int n = 0; n < RN; ++n) {
            F.RS[((((size_t)b * RN + n) * RH + h) * RDV + e) * RDK + d] = (bf16)f2bf(S);
            for (int j = 0; j < RC; ++j) { const size_t row = (size_t)b * T + n * RC + j;
                S += bf2f(F.PROJ[row * NIN + C_RK + h * RDK + d]) * bf2f(F.PROJ[row * NIN + C_RV + h * RDV + e]); }
            S *= cd;
        }
    }
    for (long idx = gt; idx < (long)BATCH * HH * HDV * HDK; idx += NGT) {
        const int d = idx & 127, e = (idx >> 7) & 127, h = (idx >> 14) & 7, b = (int)(idx >> 17);
        float S = 0.f;
        for (int n = 0; n < HN; ++n) {
            F.HS[((((size_t)b * HN + n) * HH + h) * HDV + e) * HDK + d] = (bf16)f2bf(S);
            for (int j = 0; j < HC; ++j) { const size_t row = (size_t)b * T + n * HC + j;
                S += bf2f(F.PROJ[row * NIN + C_HF + h * HDK + d]) * bf2f(F.PROJ[row * NIN + C_HI + h * HDV + e]); }
            S *= F.LAM[(((size_t)b * HN + n) * HH + h) * HDK + d];
        }
    }
}

template <int C, int DV>
__device__ __forceinline__ void p5_item_naive(Frame& F, const bf16* qt, const bf16* kt, const bf16* v, const bf16* g, const bf16* ST, const float* nw, bf16* mixed) {
    LAS float* P = (LAS float*)(F.lds + RING_OFF);
    LAS float* O = P + C * (C + 1);
    __syncthreads();
    for (int idx = F.tid; idx < C * C; idx += NTHR) {
        const int i = idx / C, j = idx % C; float s = 0.f;
        if (j <= i) { const v4u* a = (const v4u*)(qt + (size_t)i * NIN); const v4u* bq = (const v4u*)(kt + (size_t)j * NIN);
            for (int k = 0; k < 16; ++k) { const v4u av = a[k], bv = bq[k];
                s += bflo(av.x) * bflo(bv.x) + bfhi(av.x) * bfhi(bv.x) + bflo(av.y) * bflo(bv.y) + bfhi(av.y) * bfhi(bv.y)
                   + bflo(av.z) * bflo(bv.z) + bfhi(av.z) * bfhi(bv.z) + bflo(av.w) * bflo(bv.w) + bfhi(av.w) * bfhi(bv.w); } }
        P[i * (C + 1) + j] = s;
    }
    __syncthreads();
    for (int i0 = 0; i0 < C; i0 += 32) {
        const int ii = F.tid >> 4, el = F.tid & 15, i = i0 + ii;
        for (int e = el; e < DV; e += 16) {
            float s = 0.f;
            for (int j = 0; j <= i; ++j) s += P[i * (C + 1) + j] * bf2f(v[(size_t)j * NIN + e]);
            const v4u* a = (const v4u*)(qt + (size_t)i * NIN); const v4u* st = (const v4u*)(ST + (size_t)e * 128);
            for (int k = 0; k < 16; ++k) { const v4u av = a[k], bv = st[k];
                s += bflo(av.x) * bflo(bv.x) + bfhi(av.x) * bfhi(bv.x) + bflo(av.y) * bflo(bv.y) + bfhi(av.y) * bfhi(bv.y)
                   + bflo(av.z) * bflo(bv.z) + bfhi(av.z) * bfhi(bv.z) + bflo(av.w) * bflo(bv.w) + bfhi(av.w) * bfhi(bv.w); }
            O[ii * DV + e] = s;
        }
        __syncthreads();
        for (int r = F.wave; r < 32; r += NWAVES) {
            float ss = 0.f;
            for (int e = F.lane; e < DV; e += 64) { const float o = O[r * DV + e]; ss += o * o; }
            const float rstd = 1.0f / sqrtf(wave_sum(ss) * (1.0f / DV) + EPS);
            for (int e = F.lane; e < DV; e += 64) { const float o = O[r * DV + e] * rstd * (nw ? nw[e] : 1.0f) * bf2f(g[(size_t)(i0 + r) * NIN + e]);
                mixed[(size_t)(i0 + r) * D + e] = (bf16)f2bf(o); }
        }
        __syncthreads();
    }
}
__device__ __forceinline__ void p5_output_naive(Frame& F) {
    constexpr int NR = BATCH * RN * RH, NHI = BATCH * HN * HH;
    for (int it = blockIdx.x; it < NR + NHI; it += F.G) {
        if (it < NR) { const int h = it % RH, n = (it / RH) % RN, b = it / (RH * RN); const size_t row0 = (size_t)b * T + n * RC;
            const bf16* base = F.PROJ + row0 * NIN;
            p5_item_naive<RC, RDV>(F, base + C_RQ + h * RDK, base + C_RK + h * RDK, base + C_RV + h * RDV, base + C_RG + h * RDV,
                                   F.RS + (((size_t)b * RN + n) * RH + h) * RDV * RDK, nullptr, F.HB + row0 * D + h * RDV);
        } else { const int i2 = it - NR; const int h = i2 % HH, n = (i2 / HH) % HN, b = i2 / (HH * HN); const size_t row0 = (size_t)b * T + n * HC;
            const bf16* base = F.PROJ + row0 * NIN;
            p5_item_naive<HC, HDV>(F, base + C_HQ + h * HDK, base + C_HF + h * HDK, base + C_HI + h * HDV, base + C_HG + h * HDV,
                                   F.HS + (((size_t)b * HN + n) * HH + h) * HDV * HDK, F.hg_norm_w + h * HDV, F.HB + row0 * D + RH * RDV + h * HDV);
        }
    }
    __syncthreads();
}

__device__ __forceinline__ void p7_final_ln(Frame& F) {
    const int gw = F.vcu * NWAVES + F.wave, NGW = F.G * NWAVES;
    for (int row = gw; row < M; row += NGW) {
        GAS f32x4* zr = (GAS f32x4*)(F.out + (size_t)row * D) + F.lane;
        f32x4 v[8]; float s = 0.f;
#pragma unroll
        for (int j = 0; j < 8; ++j) { v[j] = zr[64 * j]; s += (v[j].x + v[j].y) + (v[j].z + v[j].w); }
        const float mean = wave_sum(s) * (1.f / D); float s2 = 0.f;
#pragma unroll
        for (int j = 0; j < 8; ++j) { v[j] = v[j] - mean; s2 += (v[j].x * v[j].x + v[j].y * v[j].y) + (v[j].z * v[j].z + v[j].w * v[j].w); }
        const float rstd = 1.f / sqrtf(wave_sum(s2) * (1.f / D) + EPS);
#pragma unroll
        for (int j = 0; j < 8; ++j) { const int c0 = 4 * F.lane + 256 * j;
            const f32x4 w = *(const f32x4*)(F.ln_w + c0), bb = *(const f32x4*)(F.ln_b + c0);
            zr[64 * j] = v[j] * rstd * w + bb; }
    }
}

struct Args { const void* in[11]; float* out; unsigned char* ws; int ph_lo, ph_hi, li, pad; };
__global__ void __launch_bounds__(NTHR, 2) hymba_fwd(Args args) {
    extern __shared__ __attribute__((aligned(16))) unsigned char lds[];
    Frame F;
    F.lds = (LAS unsigned char*)lds;
    F.MISC = (volatile LAS unsigned*)(F.lds + MISC_OFF);
    F.tid = threadIdx.x; F.lane = F.tid & 63; F.wave = __builtin_amdgcn_readfirstlane(F.tid >> 6);
    F.G = gridDim.x; { const int bx = blockIdx.x; F.vcu = (F.G % 8 == 0) ? (bx % 8) * (F.G / 8) + bx / 8 : bx; }
    unsigned char* ws = args.ws;
    F.ctl = (gu32*)(ws + WS_CTL);
    F.x = (const float*)args.in[0]; F.c = (const float*)args.in[1]; F.positions = (const int*)args.in[2]; F.w_ada = (const float*)args.in[3]; F.b_ada = (const float*)args.in[4];
    F.w_in = (const float*)args.in[5]; F.lb_logits = (const float*)args.in[6]; F.hg_norm_w = (const float*)args.in[7]; F.w_out = (const float*)args.in[8];
    F.ln_w = (const float*)args.in[9]; F.ln_b = (const float*)args.in[10]; F.out = args.out;
    F.LB = (float*)(ws + WS_LB); F.GATE = (float*)(ws + WS_GATE); F.LAM = (float*)(ws + WS_LAM); F.MODP = (float*)(ws + WS_MODP); F.ROPE = (float*)(ws + WS_ROPE);
    F.WIN = (bf16*)(ws + WS_WIN); F.WOUT = (bf16*)(ws + WS_WOUT); F.HB = (bf16*)(ws + WS_H); F.PROJ = (bf16*)(ws + WS_PROJ); F.RS = (bf16*)(ws + WS_RS); F.HS = (bf16*)(ws + WS_HS);
    for (int u = F.tid; u < (LDS_BYTES - LDSCTL_OFF) / 4; u += NTHR) ((LAS unsigned*)(F.lds + LDSCTL_OFF))[u] = 0u;
    __syncthreads();
    XcdBarrier bar; bar.bar = (unsigned*)(F.ctl + CW_BAR); bar.x = 0; bar.st = nullptr;
    if (N_LAUNCHES != NPHASE) bar = xcd_barrier_post((unsigned*)(F.ctl + CW_BAR), F.MISC + 8);
#define GRID_BAR() do { if (N_LAUNCHES != NPHASE) xcd_barrier(bar); } while (0)
    const int lo = args.ph_lo, hi = args.ph_hi;
#define IN(k) (lo <= (k) && (k) < hi)
#define BOTH(k) (IN(k) && IN((k) + 1))

    if (IN(0)) { p0_prologue(F); if (BOTH(0)) GRID_BAR(); }
    if (IN(1)) { p1_modulate(F); if (BOTH(1)) GRID_BAR(); }
    if (IN(2)) {
        pg8::Gemm g{F.HB, F.WIN, M, NIN, D}; pg8::StaticOrder S; S.init(M, NIN, F.G, (int)blockIdx.x);
        pg8::EpiProj E{F.PROJ, NIN};
        pg8::gemm_phase<pg8::EpiProj, pg8::StaticOrder, true, true>(F.lds + RING_OFF, g, S, E);
        if (BOTH(2)) GRID_BAR();
    }
    if (IN(3)) { p3_transform_naive(F); if (BOTH(3)) GRID_BAR(); }
    if (IN(4)) { p4_state_naive(F); if (BOTH(4)) GRID_BAR(); }
    if (IN(5)) { p5_output_naive(F); if (BOTH(5)) GRID_BAR(); }
    if (IN(6)) {
        pg8::Gemm g{F.HB, F.WOUT, M, D, D}; pg8::StaticOrder S; S.init(M, D, F.G, (int)blockIdx.x);
        pg8::EpiZ E{F.x, F.out, D, F.GATE, T, ALPHA};
        pg8::gemm_phase<pg8::EpiZ, pg8::StaticOrder, true, true>(F.lds + RING_OFF, g, S, E);
        if (BOTH(6)) GRID_BAR();
    }
    if (IN(7)) { p7_final_ln(F); }
#undef IN
#undef BOTH
}

extern "C" void kernel_launch(void* const* d_in, const int* in_sizes, int n_in, void* d_out, int out_size, void* d_ws, size_t ws_size, hipStream_t stream) {
    static int grid = 0;
    if (grid == 0) {
        if (n_in != 11 || in_sizes[0] != M * D || out_size != M * D || ws_size < WS_END) { fprintf(stderr, "kernel_launch: unexpected shapes: n_in %d in0 %d out %d ws %zu (need %zu)\n", n_in, n_in > 0 ? in_sizes[0] : -1, out_size, ws_size, (size_t)WS_END); grid = -1; return; }
        int dev = 0, cus = 0, per_cu = 0;
        if (hipGetDevice(&dev) != hipSuccess || hipDeviceGetAttribute(&cus, hipDeviceAttributeMultiprocessorCount, dev) != hipSuccess) { fprintf(stderr, "kernel_launch: device query failed\n"); grid = -1; return; }
        if (hipFuncSetAttribute((const void*)hymba_fwd, hipFuncAttributeMaxDynamicSharedMemorySize, LDS_BYTES) != hipSuccess) { fprintf(stderr, "kernel_launch: hipFuncSetAttribute failed\n"); grid = -1; return; }
        if (hipOccupancyMaxActiveBlocksPerMultiprocessor(&per_cu, (const void*)hymba_fwd, NTHR, LDS_BYTES) != hipSuccess || per_cu < 1) { fprintf(stderr, "kernel_launch: occupancy query says %d workgroups per CU\n", per_cu); }
        (void)hipGetLastError();
        grid = cus;
    }
    if (grid < 0) return;
    if (hipMemsetAsync((char*)d_ws + WS_CTL, 0, CTL_ZERO_BYTES, stream) != hipSuccess) { fprintf(stderr, "kernel_launch: memset failed\n"); return; }
    Args a{};
    for (int i = 0; i < 11; ++i) a.in[i] = d_in[i];
    a.out = (float*)d_out; a.ws = (unsigned char*)d_ws;
    for (int li = 0; li < N_LAUNCHES; ++li) {
        a.ph_lo = (N_LAUNCHES == NPHASE) ? li : 0; a.ph_hi = (N_LAUNCHES == NPHASE) ? li + 1 : NPHASE; a.li = li;
        hipLaunchKernelGGL(hymba_fwd, dim3(grid), dim3(NTHR), LDS_BYTES, stream, a);
        const hipError_t le = hipPeekAtLastError();
        if (le != hipSuccess) { fprintf(stderr, "kernel_launch: launch %d failed: %s\n", li, hipGetErrorName(le)); break; }
    }
}
```

```cpp
#include <hip/hip_runtime.h>
#include <cstdio>
#include <cstdint>
namespace pg8 {
#define PG8_LAS __attribute__((address_space(3)))
typedef unsigned short bf16_t;
typedef short bf16x8 __attribute__((ext_vector_type(8)));
typedef float f32x4 __attribute__((ext_vector_type(4)));
typedef unsigned u32x4 __attribute__((ext_vector_type(4)));
constexpr int BM = 256, BK = 64, HALF = 128, HTB = HALF * BK * 2  , STAGE_BYTES = 8 * HTB, NXCD = 8, WGM = 8;

__host__ __device__ __forceinline__ int lds_byte(int r, int c) { const int st = (r >> 4) * 2 + (c >> 5), rr = r & 15, cc = c & 31, ob = rr * 64 + cc * 2; return st * 1024 + (ob ^ (((ob >> 9) & 1) << 5)); }
__host__ __device__ __forceinline__ void stage_rc(int b, int& R, int& C) { const int st = b / 1024, sb = b % 1024, swz = sb ^ (((sb >> 9) & 1) << 5); R = (st >> 1) * 16 + swz / 64; C = (st & 1) * 32 + (swz % 64) / 2; }
__host__ __device__ __forceinline__ int perm32(int rho) { const int n = rho >> 4, i = rho & 15; return 8 * (i >> 2) + 4 * n + (i & 3); }

struct Unit { int pm, pn; };
struct Gemm { const bf16_t* A; const bf16_t* Bt; int M, N, K; };

struct StaticOrder {
    int nM, nN, nwg, G, c;
    __host__ __device__ void init(int M, int N, int G_, int c_) { nM = M / BM; nN = N / BM; nwg = nM * nN; G = G_; c = c_; }
    __host__ __device__ bool next(int i, Unit& u) const {
        const long L = (long)i * G + c; if (L >= nwg) return false;
        int wgid = (int)L; { const int q = nwg / NXCD, r = nwg % NXCD, xcd = wgid % NXCD, off = wgid / NXCD; wgid = (xcd < r ? xcd * (q + 1) : r * (q + 1) + (xcd - r) * q) + off; }
        const int nig = WGM * nN, gid = wgid / nig, fm = gid * WGM, gsz = (nM - fm) < WGM ? (nM - fm) : WGM;
        u.pm = fm + ((wgid % nig) % gsz); u.pn = (wgid % nig) / gsz; return true;
    }
    __device__ __forceinline__ void a_ready(const Unit&) const {}
    __device__ __forceinline__ void done(const Unit&) const {}
};

__device__ __forceinline__ unsigned cvt_pk_bf16(float lo, float hi) { unsigned r; asm volatile("v_cvt_pk_bf16_f32 %0, %1, %2" : "=v"(r) : "v"(lo), "v"(hi)); return r; }
struct EpiProj {
    static constexpr bool PERM = true, AFTER_DRAIN = false;
    bf16_t* O; int ldc;
    __device__ __forceinline__ void operator()(const f32x4 (&acc)[2][2][4][2], const Unit& u, int wr, int wc, int fr, int fq) const {
        const int row0 = u.pm * BM + wr * 64 + fr, col0 = u.pn * BM + wc * 32 + 8 * fq;
#pragma unroll
        for (int ai = 0; ai < 2; ++ai)
#pragma unroll
            for (int m = 0; m < 4; ++m) { bf16_t* rowp = O + (size_t)(row0 + ai * HALF + m * 16) * ldc + col0;
#pragma unroll
                for (int bj = 0; bj < 2; ++bj) { const f32x4 v0 = acc[ai][bj][m][0], v1 = acc[ai][bj][m][1];
                    u32x4 w; w.x = cvt_pk_bf16(v0[0], v0[1]); w.y = cvt_pk_bf16(v0[2], v0[3]); w.z = cvt_pk_bf16(v1[0], v1[1]); w.w = cvt_pk_bf16(v1[2], v1[3]);
                    *(u32x4*)(rowp + bj * HALF) = w; } }
    }
};
struct EpiZ {
    static constexpr bool PERM = false, AFTER_DRAIN = false;
    const float* X; float* Z; int ldc; const float* gate; int rows_per_batch; float alpha;
    __device__ __forceinline__ void operator()(const f32x4 (&acc)[2][2][4][2], const Unit& u, int wr, int wc, int fr, int fq) const {
        const int row0 = u.pm * BM + wr * 64 + fr, col0 = u.pn * BM + wc * 32 + 4 * fq;
        const float* g = gate + (size_t)((u.pm * BM) / rows_per_batch) * ldc + col0;
        f32x4 gv[2][2];
#pragma unroll
        for (int bj = 0; bj < 2; ++bj)
#pragma unroll
            for (int n = 0; n < 2; ++n) gv[bj][n] = *(const f32x4*)(g + bj * HALF + n * 16);
#pragma unroll
        for (int ai = 0; ai < 2; ++ai)
#pragma unroll
            for (int m = 0; m < 4; ++m) { const size_t off = (size_t)(row0 + ai * HALF + m * 16) * ldc + col0;
#pragma unroll
                for (int bj = 0; bj < 2; ++bj)
#pragma unroll
                    for (int n = 0; n < 2; ++n) { const f32x4 xv = *(const f32x4*)(X + off + bj * HALF + n * 16);
                        *(f32x4*)(Z + off + bj * HALF + n * 16) = xv * alpha + gv[bj][n] * acc[ai][bj][m][n]; }
                asm volatile("" ::: "memory"); }
    }
};
template <class Epi, class Sched, bool ALIGN_EPI = false, bool SP2 = false>
__device__ __forceinline__ void gemm_phase(PG8_LAS unsigned char* lds, const Gemm g, const Sched& S, const Epi& E) {
    const int tid = threadIdx.x, wid = __builtin_amdgcn_readfirstlane(tid >> 6), lane = tid & 63, wr = wid >> 2, wc = wid & 3, fr = lane & 15, fq = lane >> 4;
    const int K = g.K, nt = K / BK;
    unsigned voffA[2], voffB[2];
#pragma unroll
    for (int i = 0; i < 2; ++i) { int R, C; stage_rc(tid * 16 + i * 8192, R, C); const int Rb = Epi::PERM ? ((R & ~31) + perm32(R & 31)) : R;
        voffA[i] = (unsigned)(R * K + C) * 2u; voffB[i] = (unsigned)(Rb * K + C) * 2u; }
    const size_t kstep = (size_t)(BK * 2);
    const size_t hstep = (size_t)HALF * K * 2;
    const size_t tstep = 2 * hstep;
    const unsigned ldsw = (unsigned)wid * 1024u;
    const int aoff = lds_byte(wr * 64 + fr, fq * 8), boff = lds_byte(wc * 32 + fr, fq * 8);
#define PG8_SA(b, h) (((b) * 2 + (h)) * HTB)
#define PG8_SB(b, h) ((4 + (b) * 2 + (h)) * HTB)
#define PG8_STAGE(bufoff, gbase, voff) do { _Pragma("unroll") for (int _i = 0; _i < 2; ++_i) \
        __builtin_amdgcn_global_load_lds((const unsigned*)((const char*)(gbase) + (voff)[_i]), (PG8_LAS unsigned*)(lds + (bufoff) + ldsw + _i * 8192), 16, 0, 0); } while (0)
#define PG8_LDA(dst, b, h) do { _Pragma("unroll") for (int m = 0; m < 4; ++m) _Pragma("unroll") for (int k = 0; k < 2; ++k) dst[m][k] = *(const PG8_LAS bf16x8*)(lds + PG8_SA(b, h) + aoff + m * 2048 + k * 1024); } while (0)
#define PG8_LDB(dst, b, h) do { _Pragma("unroll") for (int n = 0; n < 2; ++n) _Pragma("unroll") for (int k = 0; k < 2; ++k) dst[n][k] = *(const PG8_LAS bf16x8*)(lds + PG8_SB(b, h) + boff + n * 2048 + k * 1024); } while (0)
#define PG8_MMA(ai, bj, At, Bt) do { __builtin_amdgcn_s_setprio(1); _Pragma("unroll") for (int m = 0; m < 4; ++m) _Pragma("unroll") for (int n = 0; n < 2; ++n) _Pragma("unroll") for (int k = 0; k < 2; ++k) \
        acc[ai][bj][m][n] = __builtin_amdgcn_mfma_f32_16x16x32_bf16(Bt[n][k], At[m][k], acc[ai][bj][m][n], 0, 0, 0); __builtin_amdgcn_s_setprio(0); } while (0)
#define PG8_WAIT_V(n) asm volatile("s_waitcnt vmcnt(" #n ")" ::: "memory")
#define PG8_WAIT_L(n) asm volatile("s_waitcnt lgkmcnt(" #n ")" ::: "memory")
#define PG8_BAR __builtin_amdgcn_s_barrier()
#define PG8_SCHED __builtin_amdgcn_sched_barrier(0)
    Unit cur, nxt; int ui = 0;
    if (!S.next(0, cur)) return;
    f32x4 acc[2][2][4][2];
#pragma unroll
    for (int a = 0; a < 2; ++a)
#pragma unroll
        for (int b = 0; b < 2; ++b)
#pragma unroll
            for (int m = 0; m < 4; ++m)
#pragma unroll
                for (int n = 0; n < 2; ++n) acc[a][b][m][n] = (f32x4){0.f, 0.f, 0.f, 0.f};
    bf16x8 At[4][2], B0[2][2], B1[2][2];
    const char* cA = (const char*)g.A + (size_t)cur.pm * tstep; const char* cB = (const char*)g.Bt + (size_t)cur.pn * tstep;
    S.a_ready(cur);
    if constexpr (SP2) {
        PG8_STAGE(PG8_SB(0, 0), cB, voffB); PG8_STAGE(PG8_SB(0, 1), cB + hstep, voffB); PG8_STAGE(PG8_SA(0, 0), cA, voffA); PG8_STAGE(PG8_SA(0, 1), cA + hstep, voffA);
        if (wr == 1) PG8_BAR;
        PG8_WAIT_V(2); PG8_BAR;
        PG8_STAGE(PG8_SB(1, 0), cB + kstep, voffB); PG8_STAGE(PG8_SA(1, 0), cA + kstep, voffA); PG8_STAGE(PG8_SB(1, 1), cB + hstep + kstep, voffB);
        PG8_WAIT_V(6); PG8_BAR;
    } else {
        PG8_STAGE(PG8_SB(0, 0), cB, voffB); PG8_STAGE(PG8_SA(0, 0), cA, voffA); PG8_STAGE(PG8_SB(0, 1), cB + hstep, voffB); PG8_STAGE(PG8_SA(0, 1), cA + hstep, voffA);
        if (wr == 1) PG8_BAR;
        PG8_WAIT_V(4); PG8_BAR;
        PG8_STAGE(PG8_SB(1, 0), cB + kstep, voffB); PG8_STAGE(PG8_SA(1, 0), cA + kstep, voffA); PG8_STAGE(PG8_SB(1, 1), cB + hstep + kstep, voffB);
        PG8_WAIT_V(6); PG8_BAR;
    }
    for (;;) {
        const bool has_next = S.next(ui + 1, nxt);
        const char* nA = has_next ? (const char*)g.A + (size_t)nxt.pm * tstep : cA; const char* nB = has_next ? (const char*)g.Bt + (size_t)nxt.pn * tstep : cB;
        for (int t = 0; t < nt; t += 2) {
            const bool last = (t == nt - 2);
            const char* a1 = cA + (size_t)(t + 1) * kstep;
            const char* a2 = last ? nA : cA + (size_t)(t + 2) * kstep; const char* b2 = last ? nB : cB + (size_t)(t + 2) * kstep;
            const char* a3 = a2 + kstep; const char* b3 = b2 + kstep;
            if (last && has_next) S.a_ready(nxt);
            if constexpr (SP2) {
            PG8_LDB(B0, 0, 0); PG8_LDB(B1, 0, 1); PG8_SCHED; PG8_LDA(At, 0, 0); PG8_STAGE(PG8_SA(1, 1), a1 + hstep, voffA);
            PG8_WAIT_V(8); PG8_WAIT_L(0); PG8_BAR; PG8_MMA(0, 0, At, B0); PG8_MMA(0, 1, At, B1); PG8_BAR; PG8_SCHED;
            PG8_LDA(At, 0, 1); PG8_STAGE(PG8_SB(0, 0), b2, voffB); PG8_STAGE(PG8_SB(0, 1), b2 + hstep, voffB); PG8_STAGE(PG8_SA(0, 0), a2, voffA);
            PG8_WAIT_V(8); PG8_WAIT_L(0); PG8_BAR; PG8_MMA(1, 0, At, B0); PG8_MMA(1, 1, At, B1); PG8_BAR; PG8_SCHED;
            PG8_LDB(B0, 1, 0); PG8_LDB(B1, 1, 1); PG8_SCHED; PG8_LDA(At, 1, 0); PG8_STAGE(PG8_SA(0, 1), a2 + hstep, voffA);
            PG8_WAIT_V(8); PG8_WAIT_L(0); PG8_BAR; PG8_MMA(0, 0, At, B0); PG8_MMA(0, 1, At, B1); PG8_BAR; PG8_SCHED;
            PG8_LDA(At, 1, 1); PG8_STAGE(PG8_SB(1, 0), b3, voffB); PG8_STAGE(PG8_SB(1, 1), b3 + hstep, voffB); PG8_STAGE(PG8_SA(1, 0), a3, voffA);
            PG8_WAIT_V(8); PG8_WAIT_L(0); PG8_BAR; PG8_MMA(1, 0, At, B0); PG8_MMA(1, 1, At, B1); PG8_BAR; PG8_SCHED;
            } else {
            PG8_LDB(B0, 0, 0); PG8_SCHED; PG8_LDA(At, 0, 0); PG8_STAGE(PG8_SA(1, 1), a1 + hstep, voffA);
            PG8_WAIT_L(8); PG8_BAR; PG8_WAIT_L(0); PG8_MMA(0, 0, At, B0); PG8_BAR; PG8_SCHED;
            PG8_LDB(B1, 0, 1); PG8_STAGE(PG8_SB(0, 0), b2, voffB);
            PG8_BAR; PG8_WAIT_L(0); PG8_MMA(0, 1, At, B1); PG8_BAR;
            PG8_LDA(At, 0, 1); PG8_STAGE(PG8_SA(0, 0), a2, voffA);
            PG8_BAR; PG8_WAIT_L(0); PG8_MMA(1, 0, At, B0); PG8_BAR; PG8_SCHED;
            PG8_STAGE(PG8_SB(0, 1), b2 + hstep, voffB);
            PG8_WAIT_V(6); PG8_BAR; PG8_MMA(1, 1, At, B1); PG8_BAR;
            PG8_LDB(B0, 1, 0); PG8_SCHED; PG8_LDA(At, 1, 0); PG8_STAGE(PG8_SA(0, 1), a2 + hstep, voffA);
            PG8_WAIT_L(8); PG8_BAR; PG8_WAIT_L(0); PG8_MMA(0, 0, At, B0); PG8_BAR; PG8_SCHED;
            PG8_LDB(B1, 1, 1); PG8_STAGE(PG8_SB(1, 0), b3, voffB);
            PG8_BAR; PG8_WAIT_L(0); PG8_MMA(0, 1, At, B1); PG8_BAR;
            PG8_LDA(At, 1, 1); PG8_STAGE(PG8_SA(1, 0), a3, voffA);
            PG8_BAR; PG8_WAIT_L(0); PG8_MMA(1, 0, At, B0); PG8_BAR; PG8_SCHED;
            PG8_STAGE(PG8_SB(1, 1), b3 + hstep, voffB);
            PG8_WAIT_V(6); PG8_BAR; PG8_MMA(1, 1, At, B1); PG8_BAR;
            }
        }
        if constexpr (ALIGN_EPI) { if (wr == 0) PG8_BAR; }
        if constexpr (!Epi::AFTER_DRAIN) { E(acc, cur, wr, wc, fr, fq); S.done(cur); }
        if (!has_next) break;
#pragma unroll
        for (int a = 0; a < 2; ++a)
#pragma unroll
            for (int b = 0; b < 2; ++b)
#pragma unroll
                for (int m = 0; m < 4; ++m)
#pragma unroll
                    for (int n = 0; n < 2; ++n) acc[a][b][m][n] = (f32x4){0.f, 0.f, 0.f, 0.f};
        cur = nxt; cA = nA; cB = nB; ++ui;
        if constexpr (ALIGN_EPI) { if (wr == 1) PG8_BAR; }
    }
    PG8_WAIT_V(0);
    if constexpr (!ALIGN_EPI) { if (wr == 0) PG8_BAR; }
    PG8_BAR;
    if constexpr (Epi::AFTER_DRAIN) { E.fused(acc, cur, wr, wc, fr, fq, lds, wid, lane); S.done(cur); }
#undef PG8_SA
#undef PG8_SB
#undef PG8_STAGE
#undef PG8_LDA
#undef PG8_LDB
#undef PG8_MMA
#undef PG8_WAIT_V
#undef PG8_WAIT_L
#undef PG8_BAR
#undef PG8_SCHED
}
}

constexpr int NWAVES = 8, NTHR = NWAVES * 64;
constexpr int BATCH = 8, T = 2048, D = 2048, M = BATCH * T, NIN = 7168, NMOD = 3 * D;
constexpr int RH = 4, RDK = 128, RDV = 256, RC = 128, RN = T / RC;
constexpr int HH = 8, HDK = 128, HDV = 128, HC = 64, HN = T / HC;
constexpr int C_RQ = 0, C_RK = 512, C_RV = 1024, C_RG = 2048, C_HQ = 3072, C_HF = 4096, C_HI = 5120, C_HG = 6144;
constexpr float EPS = 1e-6f;
constexpr float ALPHA = 1.189207115002721f;
constexpr int MOD_KS = 16;
#ifndef MK_N_LAUNCHES
#define MK_N_LAUNCHES 1
#endif
constexpr int NPHASE = 8;
constexpr int N_LAUNCHES = MK_N_LAUNCHES;

constexpr size_t MiB = 1u << 20;
constexpr size_t WS_CTL = 0, CTL_ZERO_BYTES = 64 * 1024;
constexpr size_t WS_LB = 1 * MiB;
constexpr size_t WS_GATE = WS_LB + 64 * 1024;
constexpr size_t WS_LAM = 2 * MiB;
constexpr size_t WS_MODP = 3 * MiB;
constexpr size_t WS_ROPE = 6 * MiB;
constexpr size_t WS_WIN = 14 * MiB;
constexpr size_t WS_WOUT = 43 * MiB;
constexpr size_t WS_H = 52 * MiB;
constexpr size_t WS_PROJ = 116 * MiB;
constexpr size_t WS_RS = 340 * MiB;
constexpr size_t WS_HS = 372 * MiB;
constexpr size_t WS_END = 436 * MiB;
static_assert(WS_WIN + (size_t)NIN * D * 2 <= WS_WOUT && WS_WOUT + (size_t)D * D * 2 <= WS_H && WS_H + (size_t)M * D * 2 <= WS_PROJ && WS_PROJ + (size_t)M * NIN * 2 <= WS_RS &&
              WS_RS + (size_t)BATCH * RN * RH * RDV * RDK * 2 <= WS_HS && WS_HS + (size_t)BATCH * HN * HH * HDV * HDK * 2 <= WS_END && WS_MODP + (size_t)MOD_KS * BATCH * NMOD * 4 <= WS_ROPE &&
              WS_ROPE + (size_t)BATCH * T * 128 * 4 <= WS_WIN, "d_ws map");
constexpr int CW_BAR = 1024;

constexpr int RING_OFF = 0, RING_BYTES = 131072;
constexpr int LDSCTL_OFF = RING_BYTES, MISC_OFF = LDSCTL_OFF + 320;
constexpr int LDS_BYTES = 147456;

#define GAS __attribute__((address_space(1)))
#define LAS __attribute__((address_space(3)))
typedef unsigned short bf16;
typedef unsigned v4u __attribute__((ext_vector_type(4)));
typedef unsigned v2u __attribute__((ext_vector_type(2)));
typedef float f32x4 __attribute__((ext_vector_type(4)));
typedef GAS unsigned gu32;
#define RLX_AGENT __ATOMIC_RELAXED, __HIP_MEMORY_SCOPE_AGENT
#define LDS_WAIT() asm volatile("s_waitcnt lgkmcnt(0)" ::: "memory")
#define VM_WAIT() asm volatile("s_waitcnt vmcnt(0)" ::: "memory")
__device__ __forceinline__ unsigned f2bf(float f) { unsigned u = __builtin_bit_cast(unsigned, f); return (u + 0x7fffu + ((u >> 16) & 1u)) >> 16; }
__device__ __forceinline__ unsigned pk2(float lo, float hi) { return f2bf(lo) | (f2bf(hi) << 16); }
__device__ __forceinline__ float bf2f(unsigned short b) { return __builtin_bit_cast(float, (unsigned)b << 16); }
__device__ __forceinline__ float bflo(unsigned w) { return __builtin_bit_cast(float, w << 16); }
__device__ __forceinline__ float bfhi(unsigned w) { return __builtin_bit_cast(float, w & 0xffff0000u); }
__device__ __forceinline__ float wave_sum(float v) {
#pragma unroll
    for (int o = 1; o < 64; o <<= 1) v += __shfl_xor(v, o);
    return v;
}
__device__ __forceinline__ float sigmoidf_(float x) { return 1.0f / (1.0f + __expf(-x)); }
__device__ __forceinline__ float siluf_(float x) { return x / (1.0f + __expf(-x)); }
__device__ __forceinline__ float ret_log2_gamma(int h) {
    const float e = (float)(5.0 + 7.0 * (double)h / 3.0);
    return log1pf(-exp2f(-e)) * 1.4426950408889634f;
}
#define XB_TMO      128
#define XB_XCNT(j)  (256  + 64 * (j))
#define XB_XSUB(j)  (1280 + 64 * (j))
#define XB_XGEN(j)  (2304 + 64 * (j))
#define XB_TOP      3328
#define XB_TOPGEN   3392
#define XCD_BAR_WORDS 3456
#define XB_SPIN_CAP (1u << 18)

__device__ __forceinline__ unsigned xb_ld(unsigned* p)              { return __hip_atomic_load(p, __ATOMIC_RELAXED, __HIP_MEMORY_SCOPE_AGENT); }
__device__ __forceinline__ unsigned xb_add(unsigned* p, unsigned v) { return __hip_atomic_fetch_add(p, v, __ATOMIC_RELAXED, __HIP_MEMORY_SCOPE_AGENT); }
__device__ __forceinline__ unsigned xb_xcc_id() { return (unsigned)__builtin_amdgcn_s_getreg((3 << 11) | 20) & 0xFu; }
#define XB_SPIN(cond, bar) do { unsigned _sp = 0; while (cond) { __builtin_amdgcn_s_sleep(1); \
    if ((++_sp & 255u) == 0u) { if (xb_ld(&(bar)[XB_TMO])) break; if (_sp > XB_SPIN_CAP) { atomicAdd(&(bar)[XB_TMO], 1u); break; } } } } while (0)

struct XcdBarrier {
    unsigned* bar; unsigned x;
    volatile LAS unsigned* st;
};

__device__ __forceinline__ XcdBarrier xcd_barrier_post(unsigned* bar, volatile LAS unsigned* st) {
    XcdBarrier b; b.bar = bar; b.x = xb_xcc_id(); b.st = st;
    if (threadIdx.x == 0) (void)xb_add(&bar[XB_XCNT(b.x)], 1u);
    return b;
}
__device__ __forceinline__ void xcd_barrier_complete(unsigned* bar, unsigned x, unsigned& nloc, unsigned& nx) {
    const unsigned G = gridDim.x * gridDim.y * gridDim.z;
    unsigned sum, cnt, mine, sp = 0u;
    for (;;) {
        sum = 0u; cnt = 0u; mine = 0u;
#pragma unroll
        for (unsigned j = 0; j < 16; ++j) { const unsigned c = xb_ld(&bar[XB_XCNT(j)]); sum += c; cnt += (c > 0u) ? 1u : 0u; mine = (j == x) ? c : mine; }
        if (sum == G) break;
        __builtin_amdgcn_s_sleep(1);
        if ((++sp & 255u) == 0u) { if (xb_ld(&bar[XB_TMO])) break; if (sp > XB_SPIN_CAP) { atomicAdd(&bar[XB_TMO], 1u); break; } }
    }
    nloc = mine > 0u ? mine : 1u; nx = cnt > 0u ? cnt : 1u;
}

__device__ __forceinline__ void xcd_barrier(const XcdBarrier& b) {
    asm volatile("s_waitcnt vmcnt(0)" ::: "memory");
    __syncthreads();
    if (threadIdx.x == 0) {
        unsigned* bar = b.bar;
        __builtin_amdgcn_s_waitcnt(0);
        unsigned nloc = b.st[0], nx = b.st[1];
        if (nloc == 0u) { xcd_barrier_complete(bar, b.x, nloc, nx); b.st[0] = nloc; b.st[1] = nx; }
        const unsigned old = xb_add(&bar[XB_XSUB(b.x)], 1u);
        const unsigned gen = old / nloc;
        if (old + 1u == (gen + 1u) * nloc) {
            __builtin_amdgcn_fence(__ATOMIC_RELEASE, "agent");
            asm volatile("s_waitcnt vmcnt(0)" ::: "memory");
            const unsigned og = xb_add(&bar[XB_TOP], 1u);
            const unsigned tg = og / nx;
            if (og + 1u == (tg + 1u) * nx) xb_add(&bar[XB_TOPGEN], 1u);
            else XB_SPIN(xb_ld(&bar[XB_TOPGEN]) == tg, bar);
            __builtin_amdgcn_fence(__ATOMIC_ACQUIRE, "agent");
            xb_add(&bar[XB_XGEN(b.x)], 1u);
            asm volatile("s_waitcnt vmcnt(0)" ::: "memory");
        } else {
            XB_SPIN(xb_ld(&bar[XB_XGEN(b.x)]) == gen, bar);
            __builtin_amdgcn_fence(__ATOMIC_ACQUIRE, "agent");
            asm volatile("s_waitcnt vmcnt(0)" ::: "memory");
        }
    }
    __syncthreads();
}

struct Frame {
    LAS unsigned char* lds;
    volatile LAS unsigned* MISC;
    gu32* ctl;
    int tid, lane, wave, vcu, G;
    const float *x, *c, *w_ada, *b_ada, *w_in, *lb_logits, *hg_norm_w, *w_out, *ln_w, *ln_b;
    const int* positions;
    float* out;
    float *LB, *GATE, *LAM, *MODP, *ROPE;
    bf16 *WIN, *WOUT, *HB, *PROJ, *RS, *HS;
};

__device__ __forceinline__ int win_dst_row(int n) { return n; }
__device__ __forceinline__ float win_col_scale(int n) { return n < C_RK ? 0.08838834764831845f : 1.0f; }

template <bool IS_WIN>
__device__ __forceinline__ void p0_transpose_item(const float* W, int K, int N, bf16* WT, LAS float* scr, int item, int lane) {
    const int nblk = N / 32, kb = item / nblk, nb = item % nblk, k0 = 64 * kb, n0 = 32 * nb;
#pragma unroll 8
    for (int i = 0; i < 32; ++i) { const int kk = 2 * i + (lane >> 5); scr[kk * 33 + (lane & 31)] = W[(size_t)(k0 + kk) * N + n0 + (lane & 31)]; }
    LDS_WAIT(); asm volatile("" ::: "memory");
    const int c = lane & 7;
#pragma unroll
    for (int j = 0; j < 4; ++j) { const int n = (lane >> 3) + 8 * j; const LAS float* s = scr + (8 * c) * 33 + n;
        const float sc = IS_WIN ? win_col_scale(n0 + n) : 1.0f; const int drow = IS_WIN ? win_dst_row(n0 + n) : (n0 + n);
        v4u o; o.x = pk2(s[0 * 33] * sc, s[1 * 33] * sc); o.y = pk2(s[2 * 33] * sc, s[3 * 33] * sc); o.z = pk2(s[4 * 33] * sc, s[5 * 33] * sc); o.w = pk2(s[6 * 33] * sc, s[7 * 33] * sc);
        *(GAS v4u*)(WT + (size_t)drow * K + k0 + 8 * c) = o; }
    LDS_WAIT(); asm volatile("" ::: "memory");
}

__device__ __forceinline__ void p0_prologue(Frame& F) {
    {
        LAS float* sc = (LAS float*)(F.lds + RING_OFF);
        constexpr int KS = D / MOD_KS, NCB = NMOD / NTHR;
        for (int it = blockIdx.x; it < MOD_KS * NCB; it += F.G) {
            const int s = it / NCB, cb = it % NCB, k0 = s * KS, n = cb * NTHR + F.tid;
            __syncthreads();
            for (int i = F.tid; i < BATCH * KS; i += NTHR) { const int b = i / KS, k = i % KS; sc[i] = siluf_(F.c[(size_t)b * D + k0 + k]); }
            __syncthreads();
            float acc[BATCH];
#pragma unroll
            for (int b = 0; b < BATCH; ++b) acc[b] = (s == 0) ? F.b_ada[n] : 0.f;
#pragma unroll 4
            for (int k = 0; k < KS; ++k) { const float w = F.w_ada[(size_t)(k0 + k) * NMOD + n];
#pragma unroll
                for (int b = 0; b < BATCH; ++b) acc[b] += sc[b * KS + k] * w; }
#pragma unroll
            for (int b = 0; b < BATCH; ++b) F.MODP[((size_t)s * BATCH + b) * NMOD + n] = acc[b];
        }
        __syncthreads();
    }
    {
        LAS float* scr = (LAS float*)(F.lds + RING_OFF + F.wave * 16384);
        const int gw = F.vcu * NWAVES + F.wave, NGW = F.G * NWAVES;
        constexpr int I_IN = (D / 64) * (NIN / 32), I_OUT = (D / 64) * (D / 32);
        for (int it = gw; it < I_IN + I_OUT; it += NGW) {
            if (it < I_IN) p0_transpose_item<true>(F.w_in, D, NIN, F.WIN, scr, it, F.lane);
            else p0_transpose_item<false>(F.w_out, D, D, F.WOUT, scr, it - I_IN, F.lane);
        }
    }
    {
        const int gt = blockIdx.x * NTHR + F.tid, NGT = F.G * NTHR;
        for (int idx = gt; idx < BATCH * T * 64; idx += NGT) {
            const int i = idx & 63, bt = idx >> 6;
            const float freq = (float)pow(10000.0, -(double)i / 64.0);
            const float ang = (float)F.positions[bt] * freq;
            double sn, cs; sincos((double)ang, &sn, &cs);
            F.ROPE[(size_t)bt * 128 + i] = (float)cs; F.ROPE[(size_t)bt * 128 + 64 + i] = (float)sn;
        }
        for (int idx = gt; idx < HH * HDK; idx += NGT) { const float l0 = F.lb_logits[idx], l1 = F.lb_logits[HH * HDK + idx]; const float mx = fmaxf(l0, l1);
            const float e0 = expf(l0 - mx), e1 = expf(l1 - mx); F.LB[idx] = e0 / (e0 + e1); }
    }
}

__device__ __forceinline__ void p1_modulate(Frame& F) {
    LAS float* sh = (LAS float*)(F.lds + RING_OFF);
    constexpr int ROWS_WG = 64;
    for (int blk = blockIdx.x; blk < M / ROWS_WG; blk += F.G) {
        const int b = (blk * ROWS_WG) / T;
        __syncthreads();
        for (int i = F.tid; i < 2 * D; i += NTHR) { float s = 0.f;
#pragma unroll
            for (int ks = 0; ks < MOD_KS; ++ks) s += F.MODP[((size_t)ks * BATCH + b) * NMOD + i];
            sh[i] = s; }
        if ((blk * ROWS_WG) % T == 0) {
            for (int i = F.tid; i < D; i += NTHR) { float s = 0.f;
#pragma unroll
                for (int ks = 0; ks < MOD_KS; ++ks) s += F.MODP[((size_t)ks * BATCH + b) * NMOD + 2 * D + i];
                F.GATE[(size_t)b * D + i] = s; }
        }
        __syncthreads();
        for (int r = F.wave; r < ROWS_WG; r += NWAVES) {
            const int row = blk * ROWS_WG + r;
            const GAS f32x4* xr = (const GAS f32x4*)(F.x + (size_t)row * D) + F.lane;
            f32x4 v[8]; float s = 0.f;
#pragma unroll
            for (int j = 0; j < 8; ++j) { v[j] = xr[64 * j]; s += (v[j].x + v[j].y) + (v[j].z + v[j].w); }
            const float mean = wave_sum(s) * (1.f / D); float s2 = 0.f;
#pragma unroll
            for (int j = 0; j < 8; ++j) { v[j] = v[j] - mean; s2 += (v[j].x * v[j].x + v[j].y * v[j].y) + (v[j].z * v[j].z + v[j].w * v[j].w); }
            const float rstd = 1.f / sqrtf(wave_sum(s2) * (1.f / D) + EPS);
            GAS v2u* o8 = (GAS v2u*)(F.HB + (size_t)row * D) + F.lane;
#pragma unroll
            for (int j = 0; j < 8; ++j) { const int c0 = 4 * F.lane + 256 * j;
                const f32x4 sf = *(const LAS f32x4*)(sh + c0), sc = *(const LAS f32x4*)(sh + D + c0);
                const f32x4 h = v[j] * rstd * (sc + 1.0f) + sf;
                v2u w; w.x = pk2(h.x, h.y); w.y = pk2(h.z, h.w); o8[64 * j] = w; }
        }
    }
    __syncthreads();
}

__device__ __forceinline__ void p3_transform_naive(Frame& F) {
    const long gt = (long)blockIdx.x * NTHR + F.tid, NGT = (long)F.G * NTHR;
    for (long idx = gt; idx < (long)M * 512; idx += NGT) {
        const int i = idx & 63, head = (idx >> 6) & 3, which = (idx >> 8) & 1; const int row = (int)(idx >> 9);
        bf16* p = F.PROJ + (size_t)row * NIN + (which ? C_RK : C_RQ) + head * RDK + i;
        const float x1 = bf2f(p[0]), x2 = bf2f(p[64]);
        const float cs = F.ROPE[(size_t)row * 128 + i], sn = F.ROPE[(size_t)row * 128 + 64 + i];
        const int tl = row % RC;
        const float lg = ret_log2_gamma(head);
        const float sc = exp2f((which ? -1.f : 1.f) * (float)(tl + 1) * lg);
        p[0] = (bf16)f2bf((x1 * cs - x2 * sn) * sc); p[64] = (bf16)f2bf((x1 * sn + x2 * cs) * sc);
    }
    for (long idx = gt; idx < (long)M * 2048; idx += NGT) {
        const int cc = idx & 2047; const int row = (int)(idx >> 11);
        bf16* p = F.PROJ + (size_t)row * NIN + (cc < 1024 ? C_RG + cc : C_HG + cc - 1024);
        p[0] = (bf16)f2bf(siluf_(bf2f(p[0])));
    }
    for (long idx = gt; idx < (long)BATCH * HN * HH * HDK; idx += NGT) {
        const int d = idx & 127, h = (idx >> 7) & 7, n = (idx >> 10) & 31, b = (int)(idx >> 15);
        const float lb = F.LB[h * HDK + d];
        float bs = 0.f;
        for (int s = 0; s < HC; ++s) {
            const size_t row = (size_t)b * T + n * HC + s;
            bf16* pq = F.PROJ + row * NIN + C_HQ + h * HDK + d; bf16* pf = F.PROJ + row * NIN + C_HF + h * HDK + d;
            const float q = bf2f(pq[0]), fp = bf2f(pf[0]);
            const float sg = 1.0f / (1.0f + expf(-fp)), sgn = 1.0f / (1.0f + expf(fp));
            const float f = lb + (1.0f - lb) * sg;
            bs += logf(f);
            pq[0] = (bf16)f2bf(q * expf(bs)); pf[0] = (bf16)f2bf((1.0f - lb) * sgn * expf(-bs));
        }
        F.LAM[idx] = expf(bs);
    }
}

__device__ __forceinline__ void p4_state_naive(Frame& F) {
    const long gt = (long)blockIdx.x * NTHR + F.tid, NGT = (long)F.G * NTHR;
    for (long idx = gt; idx < (long)BATCH * RH * RDV * RDK; idx += NGT) {
        const int d = idx & 127, e = (idx >> 7) & 255, h = (idx >> 15) & 3, b = (int)(idx >> 17);
        const float cd = exp2f((float)RC * ret_log2_gamma(h));
        float S = 0.f;
        for (int n = 0; n < RN; ++n) {
            F.RS[((((size_t)b * RN + n) * RH + h) * RDV + e) * RDK + d] = (bf16)f2bf(S);
            for (int j = 0; j < RC; ++j) { const size_t row = (size_t)b * T + n * RC + j;
                S += bf2f(F.PROJ[row * NIN + C_RK + h * RDK + d]) * bf2f(F.PROJ[row * NIN + C_RV + h * RDV + e]); }
            S *= cd;
        }
    }
    for (long idx = gt; idx < (long)BATCH * HH * HDV * HDK; idx += NGT) {
        const int d = idx & 127, e = (idx >> 7) & 127, h = (idx >> 14) & 7, b = (int)(idx >> 17);
        float S = 0.f;
        for (int n = 0; n < HN; ++n) {
            F.HS[((((size_t)b * HN + n) * HH + h) * HDV + e) * HDK + d] = (bf16)f2bf(S);
            for (int j = 0; j < HC; ++j) { const size_t row = (size_t)b * T + n * HC + j;
                S += bf2f(F.PROJ[row * NIN + C_HF + h * HDK + d]) * bf2f(F.PROJ[row * NIN + C_HI + h * HDV + e]); }
            S *= F.LAM[(((size_t)b * HN + n) * HH + h) * HDK + d];
        }
    }
}

template <int C, int DV>
__device__ __forceinline__ void p5_item_naive(Frame& F, const bf16* qt, const bf16* kt, const bf16* v, const bf16* g, const bf16* ST, const float* nw, bf16* mixed) {
    LAS float* P = (LAS float*)(F.lds + RING_OFF);
    LAS float* O = P + C * (C + 1);
    __syncthreads();
    for (int idx = F.tid; idx < C * C; idx += NTHR) {
        const int i = idx / C, j = idx % C; float s = 0.f;
        if (j <= i) { const v4u* a = (const v4u*)(qt + (size_t)i * NIN); const v4u* bq = (const v4u*)(kt + (size_t)j * NIN);
            for (int k = 0; k < 16; ++k) { const v4u av = a[k], bv = bq[k];
                s += bflo(av.x) * bflo(bv.x) + bfhi(av.x) * bfhi(bv.x) + bflo(av.y) * bflo(bv.y) + bfhi(av.y) * bfhi(bv.y)
                   + bflo(av.z) * bflo(bv.z) + bfhi(av.z) * bfhi(bv.z) + bflo(av.w) * bflo(bv.w) + bfhi(av.w) * bfhi(bv.w); } }
        P[i * (C + 1) + j] = s;
    }
    __syncthreads();
    for (int i0 = 0; i0 < C; i0 += 32) {
        const int ii = F.tid >> 4, el = F.tid & 15, i = i0 + ii;
        for (int e = el; e < DV; e += 16) {
            float s = 0.f;
            for (int j = 0; j <= i; ++j) s += P[i * (C + 1) + j] * bf2f(v[(size_t)j * NIN + e]);
            const v4u* a = (const v4u*)(qt + (size_t)i * NIN); const v4u* st = (const v4u*)(ST + (size_t)e * 128);
            for (int k = 0; k < 16; ++k) { const v4u av = a[k], bv = st[k];
                s += bflo(av.x) * bflo(bv.x) + bfhi(av.x) * bfhi(bv.x) + bflo(av.y) * bflo(bv.y) + bfhi(av.y) * bfhi(bv.y)
                   + bflo(av.z) * bflo(bv.z) + bfhi(av.z) * bfhi(bv.z) + bflo(av.w) * bflo(bv.w) + bfhi(av.w) * bfhi(bv.w); }
            O[ii * DV + e] = s;
        }
        __syncthreads();
        for (int r = F.wave; r < 32; r += NWAVES) {
            float ss = 0.f;
            for (int e = F.lane; e < DV; e += 64) { const float o = O[r * DV + e]; ss += o * o; }
            const float rstd = 1.0f / sqrtf(wave_sum(ss) * (1.0f / DV) + EPS);
            for (int e = F.lane; e < DV; e += 64) { const float o = O[r * DV + e] * rstd * (nw ? nw[e] : 1.0f) * bf2f(g[(size_t)(i0 + r) * NIN + e]);
                mixed[(size_t)(i0 + r) * D + e] = (bf16)f2bf(o); }
        }
        __syncthreads();
    }
}
__device__ __forceinline__ void p5_output_naive(Frame& F) {
    constexpr int NR = BATCH * RN * RH, NHI = BATCH * HN * HH;
    for (int it = blockIdx.x; it < NR + NHI; it += F.G) {
        if (it < NR) { const int h = it % RH, n = (it / RH) % RN, b = it / (RH * RN); const size_t row0 = (size_t)b * T + n * RC;
            const bf16* base = F.PROJ + row0 * NIN;
            p5_item_naive<RC, RDV>(F, base + C_RQ + h * RDK, base + C_RK + h * RDK, base + C_RV + h * RDV, base + C_RG + h * RDV,
                                   F.RS + (((size_t)b * RN + n) * RH + h) * RDV * RDK, nullptr, F.HB + row0 * D + h * RDV);
        } else { const int i2 = it - NR; const int h = i2 % HH, n = (i2 / HH) % HN, b = i2 / (HH * HN); const size_t row0 = (size_t)b * T + n * HC;
            const bf16* base = F.PROJ + row0 * NIN;
            p5_item_naive<HC, HDV>(F, base + C_HQ + h * HDK, base + C_HF + h * HDK, base + C_HI + h * HDV, base + C_HG + h * HDV,
                                   F.HS + (((size_t)b * HN + n) * HH + h) * HDV * HDK, F.hg_norm_w + h * HDV, F.HB + row0 * D + RH * RDV + h * HDV);
        }
    }
    __syncthreads();
}

__device__ __forceinline__ void p7_final_ln(Frame& F) {
    const int gw = F.vcu * NWAVES + F.wave, NGW = F.G * NWAVES;
    for (int row = gw; row < M; row += NGW) {
        GAS f32x4* zr = (GAS f32x4*)(F.out + (size_t)row * D) + F.lane;
        f32x4 v[8]; float s = 0.f;
#pragma unroll
        for (int j = 0; j < 8; ++j) { v[j] = zr[64 * j]; s += (v[j].x + v[j].y) + (v[j].z + v[j].w); }
        const float mean = wave_sum(s) * (1.f / D); float s2 = 0.f;
#pragma unroll
        for (int j = 0; j < 8; ++j) { v[j] = v[j] - mean; s2 += (v[j].x * v[j].x + v[j].y * v[j].y) + (v[j].z * v[j].z + v[j].w * v[j].w); }
        const float rstd = 1.f / sqrtf(wave_sum(s2) * (1.f / D) + EPS);
#pragma unroll
        for (int j = 0; j < 8; ++j) { const int c0 = 4 * F.lane + 256 * j;
            const f32x4 w = *(const f32x4*)(F.ln_w + c0), bb = *(const f32x4*)(F.ln_b + c0);
            zr[64 * j] = v[j] * rstd * w + bb; }
    }
}

typedef short bf16x8 __attribute__((ext_vector_type(8)));
typedef short s16x4 __attribute__((ext_vector_type(4)));
typedef float f32x16 __attribute__((ext_vector_type(16)));
#define MFMA32(a, b, c) __builtin_amdgcn_mfma_f32_32x32x16_bf16((a), (b), (c), 0, 0, 0)
__device__ __forceinline__ int rimg(int row, int col) { return row * 256 + ((col * 2) ^ ((row & 15) << 4)); }
__device__ __forceinline__ int timg(int row, int col) { return row * 256 + ((col * 2) ^ ((row & 3) << 6)); }
__device__ __forceinline__ s16x4 ds_tr(const LAS unsigned char* p) { typedef short v4s __attribute__((ext_vector_type(4))); return __builtin_amdgcn_ds_read_tr16_b64_v4i16((LAS v4s*)p); }
__device__ __forceinline__ bf16x8 frag_tr(const LAS unsigned char* img, int k0, int c0, int lane) {
    const int h = lane >> 5, g1 = (lane >> 4) & 1, q = (lane >> 2) & 3, p = lane & 3;
    const s16x4 lo = ds_tr(img + timg(k0 + 8 * h + q, c0 + 16 * g1 + 4 * p));
    const s16x4 hi = ds_tr(img + timg(k0 + 8 * h + 4 + q, c0 + 16 * g1 + 4 * p));
    return __builtin_shufflevector(lo, hi, 0, 1, 2, 3, 4, 5, 6, 7);
}
template <int R, int NC, bool TR>
__device__ __forceinline__ void tile_to_lds(LAS unsigned char* img, const bf16* g, int pitch, int tid) {
    constexpr int PR = NC / 8;
#pragma unroll
    for (int idx0 = 0; idx0 < R * PR; idx0 += NTHR) { const int idx = idx0 + tid; const int row = idx / PR, c8 = idx % PR;
        const v4u t = *(const v4u*)(g + (size_t)row * pitch + c8 * 8);
        *(LAS v4u*)(img + (TR ? timg(row, c8 * 8) : rimg(row, c8 * 8))) = t; }
}

constexpr int P5_R0 = 0, P5_R1 = 32768, P5_R2 = 65536, P5_R3 = 98304, P5_RED = LDSCTL_OFF + 1024;
template <int C, int DV>
__device__ __forceinline__ void p5_item(Frame& F, const bf16* qt, const bf16* kt, const bf16* v, const bf16* g, const bf16* ST, const float* nw, bf16* mixed) {
    constexpr int NIB = C / 32, NEH = DV / 128;
    constexpr int NIW = NIB / 2;
    LAS unsigned char* R0 = F.lds + P5_R0; LAS unsigned char* R1 = F.lds + P5_R1; LAS unsigned char* R2 = F.lds + P5_R2; LAS unsigned char* R3 = F.lds + P5_R3;
    LAS float* RED = (LAS float*)(F.lds + P5_RED);
    const int lane = F.lane, w = F.wave, r = lane & 31, h = lane >> 5, t = w & 3, q = w >> 2;
    __syncthreads();
    tile_to_lds<C, 128, false>(R0, qt, NIN, F.tid);
    tile_to_lds<C, 128, false>(R1, kt, NIN, F.tid);
    tile_to_lds<C, 128, true>(R2, v, NIN, F.tid);
    bf16x8 sf[8];
#pragma unroll
    for (int s = 0; s < 8; ++s) sf[s] = *(const bf16x8*)(ST + (size_t)(32 * t + r) * 128 + 16 * s + 8 * h);
    __syncthreads();
    for (int blk = w; blk < NIB * NIB; blk += NWAVES) {
        const int ib = blk / NIB, jb = blk % NIB;
        if (jb > ib) continue;
        f32x16 X;
#pragma unroll
        for (int i = 0; i < 16; ++i) X[i] = 0.f;
#pragma unroll
        for (int s = 0; s < 8; ++s) {
            const bf16x8 a = *(const LAS bf16x8*)(R1 + rimg(jb * 32 + r, 16 * s + 8 * h));
            const bf16x8 b = *(const LAS bf16x8*)(R0 + rimg(ib * 32 + r, 16 * s + 8 * h));
            X = MFMA32(a, b, X);
        }
        if (jb == ib) {
#pragma unroll
            for (int rr = 0; rr < 16; ++rr) { const int j = (rr & 3) + 8 * (rr >> 2) + 4 * h; if (j > r) X[rr] = 0.f; }
        }
#pragma unroll
        for (int gq = 0; gq < 4; ++gq) { v2u pw; pw.x = pk2(X[4 * gq], X[4 * gq + 1]); pw.y = pk2(X[4 * gq + 2], X[4 * gq + 3]);
            *(LAS v2u*)(R3 + rimg(ib * 32 + r, jb * 32 + 8 * gq + 4 * h)) = pw; }
    }
    __syncthreads();
    v4u vh[(NEH == 2) ? (C * 16 / NTHR) : 1];
    if (NEH == 2) {
#pragma unroll
        for (int k = 0; k < C * 16 / NTHR; ++k) { const int idx = k * NTHR + F.tid; vh[k] = *(const v4u*)(v + (size_t)(idx / 16) * NIN + 128 + (idx % 16) * 8); }
    }
    f32x16 acc[NEH][NIW];
#pragma unroll
    for (int p = 0; p < NEH; ++p) {
        const LAS unsigned char* RV = (p == 0) ? R2 : R1;
        if (p == 1) {
#pragma unroll
            for (int k = 0; k < C * 16 / NTHR; ++k) { const int idx = k * NTHR + F.tid; *(LAS v4u*)(R1 + timg(idx / 16, (idx % 16) * 8)) = vh[k]; }
#pragma unroll
            for (int s = 0; s < 8; ++s) sf[s] = *(const bf16x8*)(ST + (size_t)(128 + 32 * t + r) * 128 + 16 * s + 8 * h);
            __syncthreads();
        }
#pragma unroll
        for (int iw = 0; iw < NIW; ++iw) {
            const int ib = q * NIW + iw;
            f32x16 a_;
#pragma unroll
            for (int i = 0; i < 16; ++i) a_[i] = 0.f;
            for (int jb = 0; jb <= ib; ++jb) {
#pragma unroll
                for (int s = 0; s < 2; ++s) {
                    const bf16x8 a = frag_tr(RV, jb * 32 + 16 * s, 32 * t, lane);
                    const bf16x8 b = *(const LAS bf16x8*)(R3 + rimg(ib * 32 + r, jb * 32 + 16 * s + 8 * h));
                    a_ = MFMA32(a, b, a_);
                }
            }
#pragma unroll
            for (int s = 0; s < 8; ++s) {
                const bf16x8 b = *(const LAS bf16x8*)(R0 + rimg(ib * 32 + r, 16 * s + 8 * h));
                a_ = MFMA32(sf[s], b, a_);
            }
            acc[p][iw] = a_;
        }
    }
    float ss[NIW];
#pragma unroll
    for (int iw = 0; iw < NIW; ++iw) { float s_ = 0.f;
#pragma unroll
        for (int p = 0; p < NEH; ++p)
#pragma unroll
            for (int i = 0; i < 16; ++i) s_ += acc[p][iw][i] * acc[p][iw][i];
        s_ += __shfl_xor(s_, 32);
        ss[iw] = s_; }
    if (h == 0) {
#pragma unroll
        for (int iw = 0; iw < NIW; ++iw) RED[w * 64 + iw * 32 + r] = ss[iw];
    }
    __syncthreads();
    float rstd[NIW];
#pragma unroll
    for (int iw = 0; iw < NIW; ++iw) { float s_ = 0.f;
#pragma unroll
        for (int tt = 0; tt < 4; ++tt) s_ += RED[(q * 4 + tt) * 64 + iw * 32 + r];
        rstd[iw] = 1.0f / sqrtf(s_ * (1.0f / DV) + EPS); }
#pragma unroll
    for (int p = 0; p < NEH; ++p)
#pragma unroll
        for (int iw = 0; iw < NIW; ++iw) { const int i = (q * NIW + iw) * 32 + r;
#pragma unroll
            for (int gq = 0; gq < 4; ++gq) { const int e = 128 * p + 32 * t + 8 * gq + 4 * h;
                const v2u gw = *(const v2u*)(g + (size_t)i * NIN + e);
                f32x4 o; o.x = acc[p][iw][4 * gq] * bflo(gw.x); o.y = acc[p][iw][4 * gq + 1] * bfhi(gw.x); o.z = acc[p][iw][4 * gq + 2] * bflo(gw.y); o.w = acc[p][iw][4 * gq + 3] * bfhi(gw.y);
                o = o * rstd[iw];
                if (nw) o = o * *(const f32x4*)(nw + e);
                v2u ow; ow.x = pk2(o.x, o.y); ow.y = pk2(o.z, o.w);
                *(v2u*)(mixed + (size_t)i * D + e) = ow; } }
}
__device__ __forceinline__ void p5_output(Frame& F) {
    constexpr int NR = BATCH * RN * RH, NHI = BATCH * HN * HH;
    for (int it = blockIdx.x; it < NR + NHI; it += F.G) {
        if (it < NR) { const int h = it % RH, n = (it / RH) % RN, b = it / (RH * RN); const size_t row0 = (size_t)b * T + n * RC;
            const bf16* base = F.PROJ + row0 * NIN;
            p5_item<RC, RDV>(F, base + C_RQ + h * RDK, base + C_RK + h * RDK, base + C_RV + h * RDV, base + C_RG + h * RDV,
                             F.RS + (((size_t)b * RN + n) * RH + h) * RDV * RDK, nullptr, F.HB + row0 * D + h * RDV);
        } else { const int i2 = it - NR; const int h = i2 % HH, n = (i2 / HH) % HN, b = i2 / (HH * HN); const size_t row0 = (size_t)b * T + n * HC;
            const bf16* base = F.PROJ + row0 * NIN;
            p5_item<HC, HDV>(F, base + C_HQ + h * HDK, base + C_HF + h * HDK, base + C_HI + h * HDV, base + C_HG + h * HDV,
                             F.HS + (((size_t)b * HN + n) * HH + h) * HDV * HDK, F.hg_norm_w + h * HDV, F.HB + row0 * D + RH * RDV + h * HDV);
        }
    }
    __syncthreads();
}

template <int C, int NCH, int DV, bool RET>
__device__ __forceinline__ void p4_unit(Frame& F, const bf16* kt, const bf16* v, bf16* ST, const float* lam, float cd) {
    constexpr size_t st_n = (size_t)(RET ? RH : HH) * DV * 128;
    constexpr int KP = C * 16 / NTHR, VP = C * 8 / NTHR;
    const int lane = F.lane, w = F.wave, r = lane & 31, h = lane >> 5, et = w & 1, dt = w >> 1;
    LAS unsigned char* buf[2] = {F.lds, F.lds + 65536};
    v4u kr[KP], vr[VP];
    f32x16 S;
#pragma unroll
    for (int i = 0; i < 16; ++i) S[i] = 0.f;
    __syncthreads();
#pragma unroll
    for (int k = 0; k < KP; ++k) { const int idx = k * NTHR + F.tid; *(LAS v4u*)(buf[0] + timg(idx / 16, (idx % 16) * 8)) = *(const v4u*)(kt + (size_t)(idx / 16) * NIN + (idx % 16) * 8); }
#pragma unroll
    for (int k = 0; k < VP; ++k) { const int idx = k * NTHR + F.tid; *(LAS v4u*)(buf[0] + 32768 + timg(idx / 8, (idx % 8) * 8)) = *(const v4u*)(v + (size_t)(idx / 8) * NIN + (idx % 8) * 8); }
    __syncthreads();
    for (int n = 0; n < NCH; ++n) {
        const LAS unsigned char* cb = buf[n & 1]; LAS unsigned char* nb = buf[(n + 1) & 1];
        if (n + 1 < NCH) {
            const bf16* ktn = kt + (size_t)(n + 1) * C * NIN; const bf16* vn = v + (size_t)(n + 1) * C * NIN;
#pragma unroll
            for (int k = 0; k < KP; ++k) { const int idx = k * NTHR + F.tid; kr[k] = *(const v4u*)(ktn + (size_t)(idx / 16) * NIN + (idx % 16) * 8); }
#pragma unroll
            for (int k = 0; k < VP; ++k) { const int idx = k * NTHR + F.tid; vr[k] = *(const v4u*)(vn + (size_t)(idx / 8) * NIN + (idx % 8) * 8); }
        }
        bf16* stp = ST + (size_t)n * st_n + (size_t)(32 * et + r) * 128 + 32 * dt + 4 * h;
#pragma unroll
        for (int gq = 0; gq < 4; ++gq) { v2u pw; pw.x = pk2(S[4 * gq], S[4 * gq + 1]); pw.y = pk2(S[4 * gq + 2], S[4 * gq + 3]); *(v2u*)(stp + 8 * gq) = pw; }
#pragma unroll
        for (int s = 0; s < C / 16; ++s) {
            const bf16x8 a = frag_tr(cb, 16 * s, 32 * dt, lane);
            const bf16x8 b = frag_tr(cb + 32768, 16 * s, 32 * et, lane);
            S = MFMA32(a, b, S);
        }
        if (RET) {
#pragma unroll
            for (int i = 0; i < 16; ++i) S[i] *= cd;
        } else {
            const float* lp = lam + (size_t)n * (HH * HDK) + 32 * dt + 4 * h;
#pragma unroll
            for (int gq = 0; gq < 4; ++gq) { const f32x4 l4 = *(const f32x4*)(lp + 8 * gq);
                S[4 * gq] *= l4.x; S[4 * gq + 1] *= l4.y; S[4 * gq + 2] *= l4.z; S[4 * gq + 3] *= l4.w; }
        }
        if (n + 1 < NCH) {
#pragma unroll
            for (int k = 0; k < KP; ++k) { const int idx = k * NTHR + F.tid; *(LAS v4u*)(nb + timg(idx / 16, (idx % 16) * 8)) = kr[k]; }
#pragma unroll
            for (int k = 0; k < VP; ++k) { const int idx = k * NTHR + F.tid; *(LAS v4u*)(nb + 32768 + timg(idx / 8, (idx % 8) * 8)) = vr[k]; }
        }
        __syncthreads();
    }
}
__device__ __forceinline__ void p4_state(Frame& F) {
    constexpr int NRU = BATCH * RH * (RDV / 64), NHU = BATCH * HH * (HDV / 64);
    for (int it = blockIdx.x; it < NRU + NHU; it += F.G) {
        if (it < NRU) { const int es = it % 4, h = (it / 4) % RH, b = it / (4 * RH);
            const bf16* base = F.PROJ + (size_t)b * T * NIN;
            p4_unit<RC, RN, RDV, true>(F, base + C_RK + h * RDK, base + C_RV + h * RDV + 64 * es, F.RS + (((size_t)b * RN) * RH + h) * RDV * RDK + (size_t)(64 * es) * 128, nullptr,
                                       exp2f((float)RC * ret_log2_gamma(h)));
        } else { const int i2 = it - NRU; const int es = i2 % 2, h = (i2 / 2) % HH, b = i2 / (2 * HH);
            const bf16* base = F.PROJ + (size_t)b * T * NIN;
            p4_unit<HC, HN, HDV, false>(F, base + C_HF + h * HDK, base + C_HI + h * HDV + 64 * es, F.HS + (((size_t)b * HN) * HH + h) * HDV * HDK + (size_t)(64 * es) * 128,
                                        F.LAM + ((size_t)b * HN * HH + h) * HDK, 1.0f);
        }
    }
    __syncthreads();
}

struct Args { const void* in[11]; float* out; unsigned char* ws; int ph_lo, ph_hi, li, pad; };
__global__ void __launch_bounds__(NTHR, 2) hymba_fwd(Args args) {
    extern __shared__ __attribute__((aligned(16))) unsigned char lds[];
    Frame F;
    F.lds = (LAS unsigned char*)lds;
    F.MISC = (volatile LAS unsigned*)(F.lds + MISC_OFF);
    F.tid = threadIdx.x; F.lane = F.tid & 63; F.wave = __builtin_amdgcn_readfirstlane(F.tid >> 6);
    F.G = gridDim.x; { const int bx = blockIdx.x; F.vcu = (F.G % 8 == 0) ? (bx % 8) * (F.G / 8) + bx / 8 : bx; }
    unsigned char* ws = args.ws;
    F.ctl = (gu32*)(ws + WS_CTL);
    F.x = (const float*)args.in[0]; F.c = (const float*)args.in[1]; F.positions = (const int*)args.in[2]; F.w_ada = (const float*)args.in[3]; F.b_ada = (const float*)args.in[4];
    F.w_in = (const float*)args.in[5]; F.lb_logits = (const float*)args.in[6]; F.hg_norm_w = (const float*)args.in[7]; F.w_out = (const float*)args.in[8];
    F.ln_w = (const float*)args.in[9]; F.ln_b = (const float*)args.in[10]; F.out = args.out;
    F.LB = (float*)(ws + WS_LB); F.GATE = (float*)(ws + WS_GATE); F.LAM = (float*)(ws + WS_LAM); F.MODP = (float*)(ws + WS_MODP); F.ROPE = (float*)(ws + WS_ROPE);
    F.WIN = (bf16*)(ws + WS_WIN); F.WOUT = (bf16*)(ws + WS_WOUT); F.HB = (bf16*)(ws + WS_H); F.PROJ = (bf16*)(ws + WS_PROJ); F.RS = (bf16*)(ws + WS_RS); F.HS = (bf16*)(ws + WS_HS);
    for (int u = F.tid; u < (LDS_BYTES - LDSCTL_OFF) / 4; u += NTHR) ((LAS unsigned*)(F.lds + LDSCTL_OFF))[u] = 0u;
    __syncthreads();
    XcdBarrier bar; bar.bar = (unsigned*)(F.ctl + CW_BAR); bar.x = 0; bar.st = nullptr;
    if (N_LAUNCHES != NPHASE) bar = xcd_barrier_post((unsigned*)(F.ctl + CW_BAR), F.MISC + 8);
#define GRID_BAR() do { if (N_LAUNCHES != NPHASE) xcd_barrier(bar); } while (0)
    const int lo = args.ph_lo, hi = args.ph_hi;
#define IN(k) (lo <= (k) && (k) < hi)
#define BOTH(k) (IN(k) && IN((k) + 1))

    if (IN(0)) { p0_prologue(F); if (BOTH(0)) GRID_BAR(); }
    if (IN(1)) { p1_modulate(F); if (BOTH(1)) GRID_BAR(); }
    if (IN(2)) {
        pg8::Gemm g{F.HB, F.WIN, M, NIN, D}; pg8::StaticOrder S; S.init(M, NIN, F.G, (int)blockIdx.x);
        pg8::EpiProj E{F.PROJ, NIN};
        pg8::gemm_phase<pg8::EpiProj, pg8::StaticOrder, true, true>(F.lds + RING_OFF, g, S, E);
        if (BOTH(2)) GRID_BAR();
    }
    if (IN(3)) { p3_transform_naive(F); if (BOTH(3)) GRID_BAR(); }
    #if defined(NAIVE_P4)
    if (IN(4)) { p4_state_naive(F); if (BOTH(4)) GRID_BAR(); }
#else
    if (IN(4)) { p4_state(F); if (BOTH(4)) GRID_BAR(); }
#endif
    #if defined(NAIVE_P5)
    if (IN(5)) { p5_output_naive(F); if (BOTH(5)) GRID_BAR(); }
#else
    if (IN(5)) { p5_output(F); if (BOTH(5)) GRID_BAR(); }
#endif
    if (IN(6)) {
        pg8::Gemm g{F.HB, F.WOUT, M, D, D}; pg8::StaticOrder S; S.init(M, D, F.G, (int)blockIdx.x);
        pg8::EpiZ E{F.x, F.out, D, F.GATE, T, ALPHA};
        pg8::gemm_phase<pg8::EpiZ, pg8::StaticOrder, true, true>(F.lds + RING_OFF, g, S, E);
        if (BOTH(6)) GRID_BAR();
    }
    if (IN(7)) { p7_final_ln(F); }
#undef IN
#undef BOTH
}

extern "C" void kernel_launch(void* const* d_in, const int* in_sizes, int n_in, void* d_out, int out_size, void* d_ws, size_t ws_size, hipStream_t stream) {
    static int grid = 0;
    if (grid == 0) {
        if (n_in != 11 || in_sizes[0] != M * D || out_size != M * D || ws_size < WS_END) { fprintf(stderr, "kernel_launch: unexpected shapes: n_in %d in0 %d out %d ws %zu (need %zu)\n", n_in, n_in > 0 ? in_sizes[0] : -1, out_size, ws_size, (size_t)WS_END); grid = -1; return; }
        int dev = 0, cus = 0, per_cu = 0;
        if (hipGetDevice(&dev) != hipSuccess || hipDeviceGetAttribute(&cus, hipDeviceAttributeMultiprocessorCount, dev) != hipSuccess) { fprintf(stderr, "kernel_launch: device query failed\n"); grid = -1; return; }
        if (hipFuncSetAttribute((const void*)hymba_fwd, hipFuncAttributeMaxDynamicSharedMemorySize, LDS_BYTES) != hipSuccess) { fprintf(stderr, "kernel_launch: hipFuncSetAttribute failed\n"); grid = -1; return; }
        if (hipOccupancyMaxActiveBlocksPerMultiprocessor(&per_cu, (const void*)hymba_fwd, NTHR, LDS_BYTES) != hipSuccess || per_cu < 1) { fprintf(stderr, "kernel_launch: occupancy query says %d workgroups per CU\n", per_cu); }
        (void)hipGetLastError();
        grid = cus;
    }
    if (grid < 0) return;
    if (hipMemsetAsync((char*)d_ws + WS_CTL, 0, CTL_ZERO_BYTES, stream) != hipSuccess) { fprintf(stderr, "kernel_launch: memset failed\n"); return; }
    Args a{};
    for (int i = 0; i < 11; ++i) a.in[i] = d_in[i];
    a.out = (float*)d_out; a.ws = (unsigned char*)d_ws;
    for (int li = 0; li < N_LAUNCHES; ++li) {
        a.ph_lo = (N_LAUNCHES == NPHASE) ? li : 0; a.ph_hi = (N_LAUNCHES == NPHASE) ? li + 1 : NPHASE; a.li = li;
        hipLaunchKernelGGL(hymba_fwd, dim3(grid), dim3(NTHR), LDS_BYTES, stream, a);
        const hipError_t le = hipPeekAtLastError();
        if (le != hipSuccess) { fprintf(stderr, "kernel_launch: launch %d failed: %s\n", li, hipGetErrorName(le)); break; }
    }
}
```

```cpp
#include <hip/hip_runtime.h>
#include <cstdio>
#include <cstdint>
namespace pg8 {
#define PG8_LAS __attribute__((address_space(3)))
typedef unsigned short bf16_t;
typedef short bf16x8 __attribute__((ext_vector_type(8)));
typedef float f32x4 __attribute__((ext_vector_type(4)));
typedef unsigned u32x4 __attribute__((ext_vector_type(4)));
constexpr int BM = 256, BK = 64, HALF = 128, HTB = HALF * BK * 2  , STAGE_BYTES = 8 * HTB, NXCD = 8, WGM = 8;

__host__ __device__ __forceinline__ int lds_byte(int r, int c) { const int st = (r >> 4) * 2 + (c >> 5), rr = r & 15, cc = c & 31, ob = rr * 64 + cc * 2; return st * 1024 + (ob ^ (((ob >> 9) & 1) << 5)); }
__host__ __device__ __forceinline__ void stage_rc(int b, int& R, int& C) { const int st = b / 1024, sb = b % 1024, swz = sb ^ (((sb >> 9) & 1) << 5); R = (st >> 1) * 16 + swz / 64; C = (st & 1) * 32 + (swz % 64) / 2; }
__host__ __device__ __forceinline__ int perm32(int rho) { const int n = rho >> 4, i = rho & 15; return 8 * (i >> 2) + 4 * n + (i & 3); }

struct Unit { int pm, pn; };
struct Gemm { const bf16_t* A; const bf16_t* Bt; int M, N, K; };

struct StaticOrder {
    int nM, nN, nwg, G, c;
    __host__ __device__ void init(int M, int N, int G_, int c_) { nM = M / BM; nN = N / BM; nwg = nM * nN; G = G_; c = c_; }
    __host__ __device__ bool next(int i, Unit& u) const {
        const long L = (long)i * G + c; if (L >= nwg) return false;
        int wgid = (int)L; { const int q = nwg / NXCD, r = nwg % NXCD, xcd = wgid % NXCD, off = wgid / NXCD; wgid = (xcd < r ? xcd * (q + 1) : r * (q + 1) + (xcd - r) * q) + off; }
        const int nig = WGM * nN, gid = wgid / nig, fm = gid * WGM, gsz = (nM - fm) < WGM ? (nM - fm) : WGM;
        u.pm = fm + ((wgid % nig) % gsz); u.pn = (wgid % nig) / gsz; return true;
    }
    __device__ __forceinline__ void a_ready(const Unit&) const {}
    __device__ __forceinline__ void done(const Unit&) const {}
};

__device__ __forceinline__ unsigned cvt_pk_bf16(float lo, float hi) { unsigned r; asm volatile("v_cvt_pk_bf16_f32 %0, %1, %2" : "=v"(r) : "v"(lo), "v"(hi)); return r; }
struct EpiProj {
    static constexpr bool PERM = true, AFTER_DRAIN = false;
    bf16_t* O; int ldc;
    __device__ __forceinline__ void operator()(const f32x4 (&acc)[2][2][4][2], const Unit& u, int wr, int wc, int fr, int fq) const {
        const int row0 = u.pm * BM + wr * 64 + fr, col0 = u.pn * BM + wc * 32 + 8 * fq;
#pragma unroll
        for (int ai = 0; ai < 2; ++ai)
#pragma unroll
            for (int m = 0; m < 4; ++m) { bf16_t* rowp = O + (size_t)(row0 + ai * HALF + m * 16) * ldc + col0;
#pragma unroll
                for (int bj = 0; bj < 2; ++bj) { const f32x4 v0 = acc[ai][bj][m][0], v1 = acc[ai][bj][m][1];
                    u32x4 w; w.x = cvt_pk_bf16(v0[0], v0[1]); w.y = cvt_pk_bf16(v0[2], v0[3]); w.z = cvt_pk_bf16(v1[0], v1[1]); w.w = cvt_pk_bf16(v1[2], v1[3]);
                    *(u32x4*)(rowp + bj * HALF) = w; } }
    }
};
struct EpiZ {
    static constexpr bool PERM = false, AFTER_DRAIN = false;
    const float* X; float* Z; int ldc; const float* gate; int rows_per_batch; float alpha;
    __device__ __forceinline__ void operator()(const f32x4 (&acc)[2][2][4][2], const Unit& u, int wr, int wc, int fr, int fq) const {
        const int row0 = u.pm * BM + wr * 64 + fr, col0 = u.pn * BM + wc * 32 + 4 * fq;
        const float* g = gate + (size_t)((u.pm * BM) / rows_per_batch) * ldc + col0;
        f32x4 gv[2][2];
#pragma unroll
        for (int bj = 0; bj < 2; ++bj)
#pragma unroll
            for (int n = 0; n < 2; ++n) gv[bj][n] = *(const f32x4*)(g + bj * HALF + n * 16);
#pragma unroll
        for (int ai = 0; ai < 2; ++ai)
#pragma unroll
            for (int m = 0; m < 4; ++m) { const size_t off = (size_t)(row0 + ai * HALF + m * 16) * ldc + col0;
#pragma unroll
                for (int bj = 0; bj < 2; ++bj)
#pragma unroll
                    for (int n = 0; n < 2; ++n) { const f32x4 xv = *(const f32x4*)(X + off + bj * HALF + n * 16);
                        *(f32x4*)(Z + off + bj * HALF + n * 16) = xv * alpha + gv[bj][n] * acc[ai][bj][m][n]; }
                asm volatile("" ::: "memory"); }
    }
};
__device__ __forceinline__ float epi_sigmoid(float x) { return 1.0f / (1.0f + __expf(-x)); }
struct EpiFused {
    static constexpr bool PERM = false, AFTER_DRAIN = false;
    bf16_t* O; int ldc;
    const float* rope;
    const float* lbv;
    float* lam;
    float lg2_0, lg2_1, lg2_2, lg2_3;
    __device__ __forceinline__ void operator()(const f32x4 (&acc)[2][2][4][2], const Unit& u, int wr, int wc, int fr, int fq) const {
        const int pn = u.pn, rowb = u.pm * BM + wr * 64 + fr;
        if (pn < 4) {
            const int head = 2 * (pn & 1) + (wc >> 1), i0 = 32 * (wc & 1) + 8 * fq, colb = (pn < 2 ? 0 : 512) + head * 128 + i0;
            const float lgh = head == 0 ? lg2_0 : (head == 1 ? lg2_1 : (head == 2 ? lg2_2 : lg2_3)); const float lgs = (pn < 2) ? lgh : -lgh;
#pragma unroll
            for (int ai = 0; ai < 2; ++ai)
#pragma unroll
                for (int m = 0; m < 4; ++m) { const int row = rowb + ai * HALF + m * 16; const int tl = row & 127;
                    const float sc = exp2f((float)(tl + 1) * lgs);
                    const float* rp = rope + (size_t)row * 128 + i0;
                    const f32x4 c0 = *(const f32x4*)(rp), c1 = *(const f32x4*)(rp + 4), s0 = *(const f32x4*)(rp + 64), s1 = *(const f32x4*)(rp + 68);
                    const f32x4 a0 = acc[ai][0][m][0], a1 = acc[ai][0][m][1], b0 = acc[ai][1][m][0], b1 = acc[ai][1][m][1];
                    const f32x4 o10 = (a0 * c0 - b0 * s0) * sc, o11 = (a1 * c1 - b1 * s1) * sc, o20 = (a0 * s0 + b0 * c0) * sc, o21 = (a1 * s1 + b1 * c1) * sc;
                    bf16_t* rowp = O + (size_t)row * ldc + colb;
                    u32x4 w1; w1.x = cvt_pk_bf16(o10[0], o10[1]); w1.y = cvt_pk_bf16(o10[2], o10[3]); w1.z = cvt_pk_bf16(o11[0], o11[1]); w1.w = cvt_pk_bf16(o11[2], o11[3]);
                    u32x4 w2; w2.x = cvt_pk_bf16(o20[0], o20[1]); w2.y = cvt_pk_bf16(o20[2], o20[3]); w2.z = cvt_pk_bf16(o21[0], o21[1]); w2.w = cvt_pk_bf16(o21[2], o21[3]);
                    *(u32x4*)(rowp) = w1; *(u32x4*)(rowp + 64) = w2; }
        } else if (pn >= 12 && pn < 20) {
            const int h = pn - 12, d0 = 32 * wc + 8 * fq;
            const f32x4 lb0 = *(const f32x4*)(lbv + h * 128 + d0), lb1 = *(const f32x4*)(lbv + h * 128 + d0 + 4);
#pragma unroll
            for (int ai = 0; ai < 2; ++ai) {
                const int row0 = u.pm * BM + ai * HALF + wr * 64;
                float carry[2][4];
#pragma unroll
                for (int n = 0; n < 2; ++n)
#pragma unroll
                    for (int j = 0; j < 4; ++j) carry[n][j] = 0.f;
#pragma unroll
                for (int m = 0; m < 4; ++m) {
                    float qo[2][4], ko[2][4];
#pragma unroll
                    for (int n = 0; n < 2; ++n)
#pragma unroll
                        for (int j = 0; j < 4; ++j) {
                            const float lb = n ? lb1[j] : lb0[j];
                            const float fp = acc[ai][1][m][n][j], q = acc[ai][0][m][n][j];
                            const float e = __expf(-fp), sg = 1.0f / (1.0f + e), sgn = e * sg;
                            const float f = lb + (1.0f - lb) * sg;
                            float g = __logf(f);
#pragma unroll
                            for (int dlt = 1; dlt < 16; dlt <<= 1) { const float t = __shfl_up(g, dlt, 16); if (fr >= dlt) g += t; }
                            const float tot = __shfl(g, 15, 16);
                            const float b = carry[n][j] + g; carry[n][j] += tot;
                            const float eb = __expf(b);
                            qo[n][j] = q * eb; ko[n][j] = (1.0f - lb) * sgn / eb;
                        }
                    bf16_t* rowp = O + (size_t)(row0 + 16 * m + fr) * ldc + 3072 + h * 128 + d0;
                    u32x4 wq; wq.x = cvt_pk_bf16(qo[0][0], qo[0][1]); wq.y = cvt_pk_bf16(qo[0][2], qo[0][3]); wq.z = cvt_pk_bf16(qo[1][0], qo[1][1]); wq.w = cvt_pk_bf16(qo[1][2], qo[1][3]);
                    u32x4 wk; wk.x = cvt_pk_bf16(ko[0][0], ko[0][1]); wk.y = cvt_pk_bf16(ko[0][2], ko[0][3]); wk.z = cvt_pk_bf16(ko[1][0], ko[1][1]); wk.w = cvt_pk_bf16(ko[1][2], ko[1][3]);
                    *(u32x4*)(rowp) = wq; *(u32x4*)(rowp + 1024) = wk;
                    asm volatile("" ::: "memory");
                }
                if (fr == 15) {
                    const int bidx = row0 >> 11, chunk = (row0 & 2047) >> 6;
                    float* lp = lam + (((size_t)bidx * 32 + chunk) * 8 + h) * 128 + d0;
                    f32x4 l0, l1;
#pragma unroll
                    for (int j = 0; j < 4; ++j) { l0[j] = __expf(carry[0][j]); l1[j] = __expf(carry[1][j]); }
                    *(f32x4*)(lp) = l0; *(f32x4*)(lp + 4) = l1;
                }
            }
        } else {
            const bool act = (pn >= 8 && pn < 12) || pn >= 24;
            const int col0 = pn * BM + wc * 32 + 8 * fq;
#pragma unroll
            for (int ai = 0; ai < 2; ++ai)
#pragma unroll
                for (int m = 0; m < 4; ++m) { bf16_t* rowp = O + (size_t)(rowb + ai * HALF + m * 16) * ldc + col0;
#pragma unroll
                    for (int bj = 0; bj < 2; ++bj) { f32x4 v0 = acc[ai][bj][m][0], v1 = acc[ai][bj][m][1];
                        if (act) {
#pragma unroll
                            for (int j = 0; j < 4; ++j) { v0[j] = v0[j] * epi_sigmoid(v0[j]); v1[j] = v1[j] * epi_sigmoid(v1[j]); } }
                        u32x4 w; w.x = cvt_pk_bf16(v0[0], v0[1]); w.y = cvt_pk_bf16(v0[2], v0[3]); w.z = cvt_pk_bf16(v1[0], v1[1]); w.w = cvt_pk_bf16(v1[2], v1[3]);
                        *(u32x4*)(rowp + bj * HALF) = w; } }
        }
    }
};
template <class Epi, class Sched, bool ALIGN_EPI = false, bool SP2 = false>
__device__ __forceinline__ void gemm_phase(PG8_LAS unsigned char* lds, const Gemm g, const Sched& S, const Epi& E) {
    const int tid = threadIdx.x, wid = __builtin_amdgcn_readfirstlane(tid >> 6), lane = tid & 63, wr = wid >> 2, wc = wid & 3, fr = lane & 15, fq = lane >> 4;
    const int K = g.K, nt = K / BK;
    unsigned voffA[2], voffB[2];
#pragma unroll
    for (int i = 0; i < 2; ++i) { int R, C; stage_rc(tid * 16 + i * 8192, R, C); const int Rb = Epi::PERM ? ((R & ~31) + perm32(R & 31)) : R;
        voffA[i] = (unsigned)(R * K + C) * 2u; voffB[i] = (unsigned)(Rb * K + C) * 2u; }
    const size_t kstep = (size_t)(BK * 2);
    const size_t hstep = (size_t)HALF * K * 2;
    const size_t tstep = 2 * hstep;
    const unsigned ldsw = (unsigned)wid * 1024u;
    const int aoff = lds_byte(wr * 64 + fr, fq * 8), boff = lds_byte(wc * 32 + fr, fq * 8);
#define PG8_SA(b, h) (((b) * 2 + (h)) * HTB)
#define PG8_SB(b, h) ((4 + (b) * 2 + (h)) * HTB)
#define PG8_STAGE(bufoff, gbase, voff) do { _Pragma("unroll") for (int _i = 0; _i < 2; ++_i) \
        __builtin_amdgcn_global_load_lds((const unsigned*)((const char*)(gbase) + (voff)[_i]), (PG8_LAS unsigned*)(lds + (bufoff) + ldsw + _i * 8192), 16, 0, 0); } while (0)
#define PG8_LDA(dst, b, h) do { _Pragma("unroll") for (int m = 0; m < 4; ++m) _Pragma("unroll") for (int k = 0; k < 2; ++k) dst[m][k] = *(const PG8_LAS bf16x8*)(lds + PG8_SA(b, h) + aoff + m * 2048 + k * 1024); } while (0)
#define PG8_LDB(dst, b, h) do { _Pragma("unroll") for (int n = 0; n < 2; ++n) _Pragma("unroll") for (int k = 0; k < 2; ++k) dst[n][k] = *(const PG8_LAS bf16x8*)(lds + PG8_SB(b, h) + boff + n * 2048 + k * 1024); } while (0)
#define PG8_MMA(ai, bj, At, Bt) do { __builtin_amdgcn_s_setprio(1); _Pragma("unroll") for (int m = 0; m < 4; ++m) _Pragma("unroll") for (int n = 0; n < 2; ++n) _Pragma("unroll") for (int k = 0; k < 2; ++k) \
        acc[ai][bj][m][n] = __builtin_amdgcn_mfma_f32_16x16x32_bf16(Bt[n][k], At[m][k], acc[ai][bj][m][n], 0, 0, 0); __builtin_amdgcn_s_setprio(0); } while (0)
#define PG8_WAIT_V(n) asm volatile("s_waitcnt vmcnt(" #n ")" ::: "memory")
#define PG8_WAIT_L(n) asm volatile("s_waitcnt lgkmcnt(" #n ")" ::: "memory")
#define PG8_BAR __builtin_amdgcn_s_barrier()
#define PG8_SCHED __builtin_amdgcn_sched_barrier(0)
    Unit cur, nxt; int ui = 0;
    if (!S.next(0, cur)) return;
    f32x4 acc[2][2][4][2];
#pragma unroll
    for (int a = 0; a < 2; ++a)
#pragma unroll
        for (int b = 0; b < 2; ++b)
#pragma unroll
            for (int m = 0; m < 4; ++m)
#pragma unroll
                for (int n = 0; n < 2; ++n) acc[a][b][m][n] = (f32x4){0.f, 0.f, 0.f, 0.f};
    bf16x8 At[4][2], B0[2][2], B1[2][2];
    const char* cA = (const char*)g.A + (size_t)cur.pm * tstep; const char* cB = (const char*)g.Bt + (size_t)cur.pn * tstep;
    S.a_ready(cur);
    if constexpr (SP2) {
        PG8_STAGE(PG8_SB(0, 0), cB, voffB); PG8_STAGE(PG8_SB(0, 1), cB + hstep, voffB); PG8_STAGE(PG8_SA(0, 0), cA, voffA); PG8_STAGE(PG8_SA(0, 1), cA + hstep, voffA);
        if (wr == 1) PG8_BAR;
        PG8_WAIT_V(2); PG8_BAR;
        PG8_STAGE(PG8_SB(1, 0), cB + kstep, voffB); PG8_STAGE(PG8_SA(1, 0), cA + kstep, voffA); PG8_STAGE(PG8_SB(1, 1), cB + hstep + kstep, voffB);
        PG8_WAIT_V(6); PG8_BAR;
    } else {
        PG8_STAGE(PG8_SB(0, 0), cB, voffB); PG8_STAGE(PG8_SA(0, 0), cA, voffA); PG8_STAGE(PG8_SB(0, 1), cB + hstep, voffB); PG8_STAGE(PG8_SA(0, 1), cA + hstep, voffA);
        if (wr == 1) PG8_BAR;
        PG8_WAIT_V(4); PG8_BAR;
        PG8_STAGE(PG8_SB(1, 0), cB + kstep, voffB); PG8_STAGE(PG8_SA(1, 0), cA + kstep, voffA); PG8_STAGE(PG8_SB(1, 1), cB + hstep + kstep, voffB);
        PG8_WAIT_V(6); PG8_BAR;
    }
    for (;;) {
        const bool has_next = S.next(ui + 1, nxt);
        const char* nA = has_next ? (const char*)g.A + (size_t)nxt.pm * tstep : cA; const char* nB = has_next ? (const char*)g.Bt + (size_t)nxt.pn * tstep : cB;
        for (int t = 0; t < nt; t += 2) {
            const bool last = (t == nt - 2);
            const char* a1 = cA + (size_t)(t + 1) * kstep;
            const char* a2 = last ? nA : cA + (size_t)(t + 2) * kstep; const char* b2 = last ? nB : cB + (size_t)(t + 2) * kstep;
            const char* a3 = a2 + kstep; const char* b3 = b2 + kstep;
            if (last && has_next) S.a_ready(nxt);
            if constexpr (SP2) {
            PG8_LDB(B0, 0, 0); PG8_LDB(B1, 0, 1); PG8_SCHED; PG8_LDA(At, 0, 0); PG8_STAGE(PG8_SA(1, 1), a1 + hstep, voffA);
            PG8_WAIT_V(8); PG8_WAIT_L(0); PG8_BAR; PG8_MMA(0, 0, At, B0); PG8_MMA(0, 1, At, B1); PG8_BAR; PG8_SCHED;
            PG8_LDA(At, 0, 1); PG8_STAGE(PG8_SB(0, 0), b2, voffB); PG8_STAGE(PG8_SB(0, 1), b2 + hstep, voffB); PG8_STAGE(PG8_SA(0, 0), a2, voffA);
            PG8_WAIT_V(8); PG8_WAIT_L(0); PG8_BAR; PG8_MMA(1, 0, At, B0); PG8_MMA(1, 1, At, B1); PG8_BAR; PG8_SCHED;
            PG8_LDB(B0, 1, 0); PG8_LDB(B1, 1, 1); PG8_SCHED; PG8_LDA(At, 1, 0); PG8_STAGE(PG8_SA(0, 1), a2 + hstep, voffA);
            PG8_WAIT_V(8); PG8_WAIT_L(0); PG8_BAR; PG8_MMA(0, 0, At, B0); PG8_MMA(0, 1, At, B1); PG8_BAR; PG8_SCHED;
            PG8_LDA(At, 1, 1); PG8_STAGE(PG8_SB(1, 0), b3, voffB); PG8_STAGE(PG8_SB(1, 1), b3 + hstep, voffB); PG8_STAGE(PG8_SA(1, 0), a3, voffA);
            PG8_WAIT_V(8); PG8_WAIT_L(0); PG8_BAR; PG8_MMA(1, 0, At, B0); PG8_MMA(1, 1, At, B1); PG8_BAR; PG8_SCHED;
            } else {
            PG8_LDB(B0, 0, 0); PG8_SCHED; PG8_LDA(At, 0, 0); PG8_STAGE(PG8_SA(1, 1), a1 + hstep, voffA);
            PG8_WAIT_L(8); PG8_BAR; PG8_WAIT_L(0); PG8_MMA(0, 0, At, B0); PG8_BAR; PG8_SCHED;
            PG8_LDB(B1, 0, 1); PG8_STAGE(PG8_SB(0, 0), b2, voffB);
            PG8_BAR; PG8_WAIT_L(0); PG8_MMA(0, 1, At, B1); PG8_BAR;
            PG8_LDA(At, 0, 1); PG8_STAGE(PG8_SA(0, 0), a2, voffA);
            PG8_BAR; PG8_WAIT_L(0); PG8_MMA(1, 0, At, B0); PG8_BAR; PG8_SCHED;
            PG8_STAGE(PG8_SB(0, 1), b2 + hstep, voffB);
            PG8_WAIT_V(6); PG8_BAR; PG8_MMA(1, 1, At, B1); PG8_BAR;
            PG8_LDB(B0, 1, 0); PG8_SCHED; PG8_LDA(At, 1, 0); PG8_STAGE(PG8_SA(0, 1), a2 + hstep, voffA);
            PG8_WAIT_L(8); PG8_BAR; PG8_WAIT_L(0); PG8_MMA(0, 0, At, B0); PG8_BAR; PG8_SCHED;
            PG8_LDB(B1, 1, 1); PG8_STAGE(PG8_SB(1, 0), b3, voffB);
            PG8_BAR; PG8_WAIT_L(0); PG8_MMA(0, 1, At, B1); PG8_BAR;
            PG8_LDA(At, 1, 1); PG8_STAGE(PG8_SA(1, 0), a3, voffA);
            PG8_BAR; PG8_WAIT_L(0); PG8_MMA(1, 0, At, B0); PG8_BAR; PG8_SCHED;
            PG8_STAGE(PG8_SB(1, 1), b3 + hstep, voffB);
            PG8_WAIT_V(6); PG8_BAR; PG8_MMA(1, 1, At, B1); PG8_BAR;
            }
        }
        if constexpr (ALIGN_EPI) { if (wr == 0) PG8_BAR; }
        if constexpr (!Epi::AFTER_DRAIN) { E(acc, cur, wr, wc, fr, fq); S.done(cur); }
        if (!has_next) break;
#pragma unroll
        for (int a = 0; a < 2; ++a)
#pragma unroll
            for (int b = 0; b < 2; ++b)
#pragma unroll
                for (int m = 0; m < 4; ++m)
#pragma unroll
                    for (int n = 0; n < 2; ++n) acc[a][b][m][n] = (f32x4){0.f, 0.f, 0.f, 0.f};
        cur = nxt; cA = nA; cB = nB; ++ui;
        if constexpr (ALIGN_EPI) { if (wr == 1) PG8_BAR; }
    }
    PG8_WAIT_V(0);
    if constexpr (!ALIGN_EPI) { if (wr == 0) PG8_BAR; }
    PG8_BAR;
    if constexpr (Epi::AFTER_DRAIN) { E.fused(acc, cur, wr, wc, fr, fq, lds, wid, lane); S.done(cur); }
#undef PG8_SA
#undef PG8_SB
#undef PG8_STAGE
#undef PG8_LDA
#undef PG8_LDB
#undef PG8_MMA
#undef PG8_WAIT_V
#undef PG8_WAIT_L
#undef PG8_BAR
#undef PG8_SCHED
}
}

constexpr int NWAVES = 8, NTHR = NWAVES * 64;
constexpr int BATCH = 8, T = 2048, D = 2048, M = BATCH * T, NIN = 7168, NMOD = 3 * D;
constexpr int RH = 4, RDK = 128, RDV = 256, RC = 128, RN = T / RC;
constexpr int HH = 8, HDK = 128, HDV = 128, HC = 64, HN = T / HC;
constexpr int C_RQ = 0, C_RK = 512, C_RV = 1024, C_RG = 2048, C_HQ = 3072, C_HF = 4096, C_HI = 5120, C_HG = 6144;
constexpr float EPS = 1e-6f;
constexpr float ALPHA = 1.189207115002721f;
constexpr int MOD_KS = 16;
#ifndef MK_N_LAUNCHES
#define MK_N_LAUNCHES 1
#endif
constexpr int NPHASE = 8;
constexpr int N_LAUNCHES = MK_N_LAUNCHES;

constexpr size_t MiB = 1u << 20;
constexpr size_t WS_CTL = 0, CTL_ZERO_BYTES = 64 * 1024;
constexpr size_t WS_LB = 1 * MiB;
constexpr size_t WS_GATE = WS_LB + 64 * 1024;
constexpr size_t WS_LAM = 2 * MiB;
constexpr size_t WS_MODP = 3 * MiB;
constexpr size_t WS_ROPE = 6 * MiB;
constexpr size_t WS_WIN = 14 * MiB;
constexpr size_t WS_WOUT = 43 * MiB;
constexpr size_t WS_H = 52 * MiB;
constexpr size_t WS_PROJ = 116 * MiB;
constexpr size_t WS_RS = 340 * MiB;
constexpr size_t WS_HS = 372 * MiB;
constexpr size_t WS_END = 436 * MiB;
static_assert(WS_WIN + (size_t)NIN * D * 2 <= WS_WOUT && WS_WOUT + (size_t)D * D * 2 <= WS_H && WS_H + (size_t)M * D * 2 <= WS_PROJ && WS_PROJ + (size_t)M * NIN * 2 <= WS_RS &&
              WS_RS + (size_t)BATCH * RN * RH * RDV * RDK * 2 <= WS_HS && WS_HS + (size_t)BATCH * HN * HH * HDV * HDK * 2 <= WS_END && WS_MODP + (size_t)MOD_KS * BATCH * NMOD * 4 <= WS_ROPE &&
              WS_ROPE + (size_t)BATCH * T * 128 * 4 <= WS_WIN, "d_ws map");
constexpr int CW_BAR = 1024;

constexpr int RING_OFF = 0, RING_BYTES = 131072;
constexpr int LDSCTL_OFF = RING_BYTES, MISC_OFF = LDSCTL_OFF + 320;
constexpr int LDS_BYTES = 147456;

#define GAS __attribute__((address_space(1)))
#define LAS __attribute__((address_space(3)))
typedef unsigned short bf16;
typedef unsigned v4u __attribute__((ext_vector_type(4)));
typedef unsigned v2u __attribute__((ext_vector_type(2)));
typedef float f32x4 __attribute__((ext_vector_type(4)));
typedef GAS unsigned gu32;
#define RLX_AGENT __ATOMIC_RELAXED, __HIP_MEMORY_SCOPE_AGENT
#define LDS_WAIT() asm volatile("s_waitcnt lgkmcnt(0)" ::: "memory")
#define VM_WAIT() asm volatile("s_waitcnt vmcnt(0)" ::: "memory")
__device__ __forceinline__ unsigned f2bf(float f) { unsigned u = __builtin_bit_cast(unsigned, f); return (u + 0x7fffu + ((u >> 16) & 1u)) >> 16; }
__device__ __forceinline__ unsigned pk2(float lo, float hi) { return f2bf(lo) | (f2bf(hi) << 16); }
__device__ __forceinline__ float bf2f(unsigned short b) { return __builtin_bit_cast(float, (unsigned)b << 16); }
__device__ __forceinline__ float bflo(unsigned w) { return __builtin_bit_cast(float, w << 16); }
__device__ __forceinline__ float bfhi(unsigned w) { return __builtin_bit_cast(float, w & 0xffff0000u); }
__device__ __forceinline__ float wave_sum(float v) {
#pragma unroll
    for (int o = 1; o < 64; o <<= 1) v += __shfl_xor(v, o);
    return v;
}
__device__ __forceinline__ float sigmoidf_(float x) { return 1.0f / (1.0f + __expf(-x)); }
__device__ __forceinline__ float siluf_(float x) { return x / (1.0f + __expf(-x)); }
__device__ __forceinline__ float ret_log2_gamma(int h) {
    const float e = (float)(5.0 + 7.0 * (double)h / 3.0);
    return log1pf(-exp2f(-e)) * 1.4426950408889634f;
}
#define XB_TMO      128
#define XB_XCNT(j)  (256  + 64 * (j))
#define XB_XSUB(j)  (1280 + 64 * (j))
#define XB_XGEN(j)  (2304 + 64 * (j))
#define XB_TOP      3328
#define XB_TOPGEN   3392
#define XCD_BAR_WORDS 3456
#define XB_SPIN_CAP (1u << 18)

__device__ __forceinline__ unsigned xb_ld(unsigned* p)              { return __hip_atomic_load(p, __ATOMIC_RELAXED, __HIP_MEMORY_SCOPE_AGENT); }
__device__ __forceinline__ unsigned xb_add(unsigned* p, unsigned v) { return __hip_atomic_fetch_add(p, v, __ATOMIC_RELAXED, __HIP_MEMORY_SCOPE_AGENT); }
__device__ __forceinline__ unsigned xb_xcc_id() { return (unsigned)__builtin_amdgcn_s_getreg((3 << 11) | 20) & 0xFu; }
#define XB_SPIN(cond, bar) do { unsigned _sp = 0; while (cond) { __builtin_amdgcn_s_sleep(1); \
    if ((++_sp & 255u) == 0u) { if (xb_ld(&(bar)[XB_TMO])) break; if (_sp > XB_SPIN_CAP) { atomicAdd(&(bar)[XB_TMO], 1u); break; } } } } while (0)

struct XcdBarrier {
    unsigned* bar; unsigned x;
    volatile LAS unsigned* st;
};

__device__ __forceinline__ XcdBarrier xcd_barrier_post(unsigned* bar, volatile LAS unsigned* st) {
    XcdBarrier b; b.bar = bar; b.x = xb_xcc_id(); b.st = st;
    if (threadIdx.x == 0) (void)xb_add(&bar[XB_XCNT(b.x)], 1u);
    return b;
}
__device__ __forceinline__ void xcd_barrier_complete(unsigned* bar, unsigned x, unsigned& nloc, unsigned& nx) {
    const unsigned G = gridDim.x * gridDim.y * gridDim.z;
    unsigned sum, cnt, mine, sp = 0u;
    for (;;) {
        sum = 0u; cnt = 0u; mine = 0u;
#pragma unroll
        for (unsigned j = 0; j < 16; ++j) { const unsigned c = xb_ld(&bar[XB_XCNT(j)]); sum += c; cnt += (c > 0u) ? 1u : 0u; mine = (j == x) ? c : mine; }
        if (sum == G) break;
        __builtin_amdgcn_s_sleep(1);
        if ((++sp & 255u) == 0u) { if (xb_ld(&bar[XB_TMO])) break; if (sp > XB_SPIN_CAP) { atomicAdd(&bar[XB_TMO], 1u); break; } }
    }
    nloc = mine > 0u ? mine : 1u; nx = cnt > 0u ? cnt : 1u;
}

__device__ __forceinline__ void xcd_barrier(const XcdBarrier& b) {
    asm volatile("s_waitcnt vmcnt(0)" ::: "memory");
    __syncthreads();
    if (threadIdx.x == 0) {
        unsigned* bar = b.bar;
        __builtin_amdgcn_s_waitcnt(0);
        unsigned nloc = b.st[0], nx = b.st[1];
        if (nloc == 0u) { xcd_barrier_complete(bar, b.x, nloc, nx); b.st[0] = nloc; b.st[1] = nx; }
        const unsigned old = xb_add(&bar[XB_XSUB(b.x)], 1u);
        const unsigned gen = old / nloc;
        if (old + 1u == (gen + 1u) * nloc) {
            __builtin_amdgcn_fence(__ATOMIC_RELEASE, "agent");
            asm volatile("s_waitcnt vmcnt(0)" ::: "memory");
            const unsigned og = xb_add(&bar[XB_TOP], 1u);
            const unsigned tg = og / nx;
            if (og + 1u == (tg + 1u) * nx) xb_add(&bar[XB_TOPGEN], 1u);
            else XB_SPIN(xb_ld(&bar[XB_TOPGEN]) == tg, bar);
            __builtin_amdgcn_fence(__ATOMIC_ACQUIRE, "agent");
            xb_add(&bar[XB_XGEN(b.x)], 1u);
            asm volatile("s_waitcnt vmcnt(0)" ::: "memory");
        } else {
            XB_SPIN(xb_ld(&bar[XB_XGEN(b.x)]) == gen, bar);
            __builtin_amdgcn_fence(__ATOMIC_ACQUIRE, "agent");
            asm volatile("s_waitcnt vmcnt(0)" ::: "memory");
        }
    }
    __syncthreads();
}

struct Frame {
    LAS unsigned char* lds;
    volatile LAS unsigned* MISC;
    gu32* ctl;
    int tid, lane, wave, vcu, G;
    const float *x, *c, *w_ada, *b_ada, *w_in, *lb_logits, *hg_norm_w, *w_out, *ln_w, *ln_b;
    const int* positions;
    float* out;
    float *LB, *GATE, *LAM, *MODP, *ROPE;
    bf16 *WIN, *WOUT, *HB, *PROJ, *RS, *HS;
};

#if defined(NAIVE_P3)
__device__ __forceinline__ int win_dst_row(int n) { return n; }
#else
__device__ __forceinline__ int win_dst_row(int n) {
    int pn, bj, wc, fq, nn, j;
    if (n < 1024) { const int sec = n >> 9, m = n & 511, head = m >> 7, dim = m & 127, i = dim & 63;
        bj = dim >> 6; wc = 2 * (head & 1) + (i >> 5); fq = (i >> 3) & 3; nn = (i >> 2) & 1; j = i & 3; pn = 2 * sec + (head >> 1); }
    else if (n >= C_HQ && n < C_HI) { const int sec = (n - C_HQ) >> 10, m = (n - C_HQ) & 1023, h = m >> 7, d = m & 127;
        bj = sec; wc = d >> 5; fq = (d >> 3) & 3; nn = (d >> 2) & 1; j = d & 3; pn = 12 + h; }
    else { const int c = n & 255; pn = n >> 8; bj = c >> 7; wc = (c >> 5) & 3; fq = (c >> 3) & 3; nn = (c >> 2) & 1; j = c & 3; }
    return 256 * pn + 128 * bj + 32 * wc + 16 * nn + 4 * fq + j;
}
#endif
__device__ __forceinline__ float win_col_scale(int n) { return n < C_RK ? 0.08838834764831845f : 1.0f; }

template <bool IS_WIN>
__device__ __forceinline__ void p0_transpose_item(const float* W, int K, int N, bf16* WT, LAS float* scr, int item, int lane) {
    const int nblk = N / 32, kb = item / nblk, nb = item % nblk, k0 = 64 * kb, n0 = 32 * nb;
#pragma unroll 8
    for (int i = 0; i < 32; ++i) { const int kk = 2 * i + (lane >> 5); scr[kk * 33 + (lane & 31)] = W[(size_t)(k0 + kk) * N + n0 + (lane & 31)]; }
    LDS_WAIT(); asm volatile("" ::: "memory");
    const int c = lane & 7;
#pragma unroll
    for (int j = 0; j < 4; ++j) { const int n = (lane >> 3) + 8 * j; const LAS float* s = scr + (8 * c) * 33 + n;
        const float sc = IS_WIN ? win_col_scale(n0 + n) : 1.0f; const int drow = IS_WIN ? win_dst_row(n0 + n) : (n0 + n);
        v4u o; o.x = pk2(s[0 * 33] * sc, s[1 * 33] * sc); o.y = pk2(s[2 * 33] * sc, s[3 * 33] * sc); o.z = pk2(s[4 * 33] * sc, s[5 * 33] * sc); o.w = pk2(s[6 * 33] * sc, s[7 * 33] * sc);
        *(GAS v4u*)(WT + (size_t)drow * K + k0 + 8 * c) = o; }
    LDS_WAIT(); asm volatile("" ::: "memory");
}

__device__ __forceinline__ void p0_prologue(Frame& F) {
    {
        LAS float* sc = (LAS float*)(F.lds + RING_OFF);
        constexpr int KS = D / MOD_KS, NCB = NMOD / NTHR;
        for (int it = blockIdx.x; it < MOD_KS * NCB; it += F.G) {
            const int s = it / NCB, cb = it % NCB, k0 = s * KS, n = cb * NTHR + F.tid;
            __syncthreads();
            for (int i = F.tid; i < BATCH * KS; i += NTHR) { const int b = i / KS, k = i % KS; sc[i] = siluf_(F.c[(size_t)b * D + k0 + k]); }
            __syncthreads();
            float acc[BATCH];
#pragma unroll
            for (int b = 0; b < BATCH; ++b) acc[b] = (s == 0) ? F.b_ada[n] : 0.f;
#pragma unroll 4
            for (int k = 0; k < KS; ++k) { const float w = F.w_ada[(size_t)(k0 + k) * NMOD + n];
#pragma unroll
                for (int b = 0; b < BATCH; ++b) acc[b] += sc[b * KS + k] * w; }
#pragma unroll
            for (int b = 0; b < BATCH; ++b) F.MODP[((size_t)s * BATCH + b) * NMOD + n] = acc[b];
        }
        __syncthreads();
    }
    {
        LAS float* scr = (LAS float*)(F.lds + RING_OFF + F.wave * 16384);
        const int gw = F.vcu * NWAVES + F.wave, NGW = F.G * NWAVES;
        constexpr int I_IN = (D / 64) * (NIN / 32), I_OUT = (D / 64) * (D / 32);
        for (int it = gw; it < I_IN + I_OUT; it += NGW) {
            if (it < I_IN) p0_transpose_item<true>(F.w_in, D, NIN, F.WIN, scr, it, F.lane);
            else p0_transpose_item<false>(F.w_out, D, D, F.WOUT, scr, it - I_IN, F.lane);
        }
    }
    {
        const int gt = blockIdx.x * NTHR + F.tid, NGT = F.G * NTHR;
        for (int idx = gt; idx < BATCH * T * 64; idx += NGT) {
            const int i = idx & 63, bt = idx >> 6;
            const float freq = (float)pow(10000.0, -(double)i / 64.0);
            const float ang = (float)F.positions[bt] * freq;
            double sn, cs; sincos((double)ang, &sn, &cs);
            F.ROPE[(size_t)bt * 128 + i] = (float)cs; F.ROPE[(size_t)bt * 128 + 64 + i] = (float)sn;
        }
        for (int idx = gt; idx < HH * HDK; idx += NGT) { const float l0 = F.lb_logits[idx], l1 = F.lb_logits[HH * HDK + idx]; const float mx = fmaxf(l0, l1);
            const float e0 = expf(l0 - mx), e1 = expf(l1 - mx); F.LB[idx] = e0 / (e0 + e1); }
    }
}

__device__ __forceinline__ void p1_modulate(Frame& F) {
    LAS float* sh = (LAS float*)(F.lds + RING_OFF);
    constexpr int ROWS_WG = 64;
    for (int blk = blockIdx.x; blk < M / ROWS_WG; blk += F.G) {
        const int b = (blk * ROWS_WG) / T;
        __syncthreads();
        for (int i = F.tid; i < 2 * D; i += NTHR) { float s = 0.f;
#pragma unroll
            for (int ks = 0; ks < MOD_KS; ++ks) s += F.MODP[((size_t)ks * BATCH + b) * NMOD + i];
            sh[i] = s; }
        if ((blk * ROWS_WG) % T == 0) {
            for (int i = F.tid; i < D; i += NTHR) { float s = 0.f;
#pragma unroll
                for (int ks = 0; ks < MOD_KS; ++ks) s += F.MODP[((size_t)ks * BATCH + b) * NMOD + 2 * D + i];
                F.GATE[(size_t)b * D + i] = s; }
        }
        __syncthreads();
        for (int r = F.wave; r < ROWS_WG; r += NWAVES) {
            const int row = blk * ROWS_WG + r;
            const GAS f32x4* xr = (const GAS f32x4*)(F.x + (size_t)row * D) + F.lane;
            f32x4 v[8]; float s = 0.f;
#pragma unroll
            for (int j = 0; j < 8; ++j) { v[j] = xr[64 * j]; s += (v[j].x + v[j].y) + (v[j].z + v[j].w); }
            const float mean = wave_sum(s) * (1.f / D); float s2 = 0.f;
#pragma unroll
            for (int j = 0; j < 8; ++j) { v[j] = v[j] - mean; s2 += (v[j].x * v[j].x + v[j].y * v[j].y) + (v[j].z * v[j].z + v[j].w * v[j].w); }
            const float rstd = 1.f / sqrtf(wave_sum(s2) * (1.f / D) + EPS);
            GAS v2u* o8 = (GAS v2u*)(F.HB + (size_t)row * D) + F.lane;
#pragma unroll
            for (int j = 0; j < 8; ++j) { const int c0 = 4 * F.lane + 256 * j;
                const f32x4 sf = *(const LAS f32x4*)(sh + c0), sc = *(const LAS f32x4*)(sh + D + c0);
                const f32x4 h = v[j] * rstd * (sc + 1.0f) + sf;
                v2u w; w.x = pk2(h.x, h.y); w.y = pk2(h.z, h.w); o8[64 * j] = w; }
        }
    }
    __syncthreads();
}

__device__ __forceinline__ void p3_transform_naive(Frame& F) {
    const long gt = (long)blockIdx.x * NTHR + F.tid, NGT = (long)F.G * NTHR;
    for (long idx = gt; idx < (long)M * 512; idx += NGT) {
        const int i = idx & 63, head = (idx >> 6) & 3, which = (idx >> 8) & 1; const int row = (int)(idx >> 9);
        bf16* p = F.PROJ + (size_t)row * NIN + (which ? C_RK : C_RQ) + head * RDK + i;
        const float x1 = bf2f(p[0]), x2 = bf2f(p[64]);
        const float cs = F.ROPE[(size_t)row * 128 + i], sn = F.ROPE[(size_t)row * 128 + 64 + i];
        const int tl = row % RC;
        const float lg = ret_log2_gamma(head);
        const float sc = exp2f((which ? -1.f : 1.f) * (float)(tl + 1) * lg);
        p[0] = (bf16)f2bf((x1 * cs - x2 * sn) * sc); p[64] = (bf16)f2bf((x1 * sn + x2 * cs) * sc);
    }
    for (long idx = gt; idx < (long)M * 2048; idx += NGT) {
        const int cc = idx & 2047; const int row = (int)(idx >> 11);
        bf16* p = F.PROJ + (size_t)row * NIN + (cc < 1024 ? C_RG + cc : C_HG + cc - 1024);
        p[0] = (bf16)f2bf(siluf_(bf2f(p[0])));
    }
    for (long idx = gt; idx < (long)BATCH * HN * HH * HDK; idx += NGT) {
        const int d = idx & 127, h = (idx >> 7) & 7, n = (idx >> 10) & 31, b = (int)(idx >> 15);
        const float lb = F.LB[h * HDK + d];
        float bs = 0.f;
        for (int s = 0; s < HC; ++s) {
            const size_t row = (size_t)b * T + n * HC + s;
            bf16* pq = F.PROJ + row * NIN + C_HQ + h * HDK + d; bf16* pf = F.PROJ + row * NIN + C_HF + h * HDK + d;
            const float q = bf2f(pq[0]), fp = bf2f(pf[0]);
            const float sg = 1.0f / (1.0f + expf(-fp)), sgn = 1.0f / (1.0f + expf(fp));
            const float f = lb + (1.0f - lb) * sg;
            bs += logf(f);
            pq[0] = (bf16)f2bf(q * expf(bs)); pf[0] = (bf16)f2bf((1.0f - lb) * sgn * expf(-bs));
        }
        F.LAM[idx] = expf(bs);
    }
}

__device__ __forceinline__ void p4_state_naive(Frame& F) {
    const long gt = (long)blockIdx.x * NTHR + F.tid, NGT = (long)F.G * NTHR;
    for (long idx = gt; idx < (long)BATCH * RH * RDV * RDK; idx += NGT) {
        const int d = idx & 127, e = (idx >> 7) & 255, h = (idx >> 15) & 3, b = (int)(idx >> 17);
        const float cd = exp2f((float)RC * ret_log2_gamma(h));
        float S = 0.f;
        for (int n = 0; n < RN; ++n) {
            F.RS[((((size_t)b * RN + n) * RH + h) * RDV + e) * RDK + d] = (bf16)f2bf(S);
            for (int j = 0; j < RC; ++j) { const size_t row = (size_t)b * T + n * RC + j;
                S += bf2f(F.PROJ[row * NIN + C_RK + h * RDK + d]) * bf2f(F.PROJ[row * NIN + C_RV + h * RDV + e]); }
            S *= cd;
        }
    }
    for (long idx = gt; idx < (long)BATCH * HH * HDV * HDK; idx += NGT) {
        const int d = idx & 127, e = (idx >> 7) & 127, h = (idx >> 14) & 7, b = (int)(idx >> 17);
        float S = 0.f;
        for (int n = 0; n < HN; ++n) {
            F.HS[((((size_t)b * HN + n) * HH + h) * HDV + e) * HDK + d] = (bf16)f2bf(S);
            for (int j = 0; j < HC; ++j) { const size_t row = (size_t)b * T + n * HC + j;
                S += bf2f(F.PROJ[row * NIN + C_HF + h * HDK + d]) * bf2f(F.PROJ[row * NIN + C_HI + h * HDV + e]); }
            S *= F.LAM[(((size_t)b * HN + n) * HH + h) * HDK + d];
        }
    }
}

template <int C, int DV>
__device__ __forceinline__ void p5_item_naive(Frame& F, const bf16* qt, const bf16* kt, const bf16* v, const bf16* g, const bf16* ST, const float* nw, bf16* mixed) {
    LAS float* P = (LAS float*)(F.lds + RING_OFF);
    LAS float* O = P + C * (C + 1);
    __syncthreads();
    for (int idx = F.tid; idx < C * C; idx += NTHR) {
        const int i = idx / C, j = idx % C; float s = 0.f;
        if (j <= i) { const v4u* a = (const v4u*)(qt + (size_t)i * NIN); const v4u* bq = (const v4u*)(kt + (size_t)j * NIN);
            for (int k = 0; k < 16; ++k) { const v4u av = a[k], bv = bq[k];
                s += bflo(av.x) * bflo(bv.x) + bfhi(av.x) * bfhi(bv.x) + bflo(av.y) * bflo(bv.y) + bfhi(av.y) * bfhi(bv.y)
                   + bflo(av.z) * bflo(bv.z) + bfhi(av.z) * bfhi(bv.z) + bflo(av.w) * bflo(bv.w) + bfhi(av.w) * bfhi(bv.w); } }
        P[i * (C + 1) + j] = s;
    }
    __syncthreads();
    for (int i0 = 0; i0 < C; i0 += 32) {
        const int ii = F.tid >> 4, el = F.tid & 15, i = i0 + ii;
        for (int e = el; e < DV; e += 16) {
            float s = 0.f;
            for (int j = 0; j <= i; ++j) s += P[i * (C + 1) + j] * bf2f(v[(size_t)j * NIN + e]);
            const v4u* a = (const v4u*)(qt + (size_t)i * NIN); const v4u* st = (const v4u*)(ST + (size_t)e * 128);
            for (int k = 0; k < 16; ++k) { const v4u av = a[k], bv = st[k];
                s += bflo(av.x) * bflo(bv.x) + bfhi(av.x) * bfhi(bv.x) + bflo(av.y) * bflo(bv.y) + bfhi(av.y) * bfhi(bv.y)
                   + bflo(av.z) * bflo(bv.z) + bfhi(av.z) * bfhi(bv.z) + bflo(av.w) * bflo(bv.w) + bfhi(av.w) * bfhi(bv.w); }
            O[ii * DV + e] = s;
        }
        __syncthreads();
        for (int r = F.wave; r < 32; r += NWAVES) {
            float ss = 0.f;
            for (int e = F.lane; e < DV; e += 64) { const float o = O[r * DV + e]; ss += o * o; }
            const float rstd = 1.0f / sqrtf(wave_sum(ss) * (1.0f / DV) + EPS);
            for (int e = F.lane; e < DV; e += 64) { const float o = O[r * DV + e] * rstd * (nw ? nw[e] : 1.0f) * bf2f(g[(size_t)(i0 + r) * NIN + e]);
                mixed[(size_t)(i0 + r) * D + e] = (bf16)f2bf(o); }
        }
        __syncthreads();
    }
}
__device__ __forceinline__ void p5_output_naive(Frame& F) {
    constexpr int NR = BATCH * RN * RH, NHI = BATCH * HN * HH;
    for (int it = blockIdx.x; it < NR + NHI; it += F.G) {
        if (it < NR) { const int h = it % RH, n = (it / RH) % RN, b = it / (RH * RN); const size_t row0 = (size_t)b * T + n * RC;
            const bf16* base = F.PROJ + row0 * NIN;
            p5_item_naive<RC, RDV>(F, base + C_RQ + h * RDK, base + C_RK + h * RDK, base + C_RV + h * RDV, base + C_RG + h * RDV,
                                   F.RS + (((size_t)b * RN + n) * RH + h) * RDV * RDK, nullptr, F.HB + row0 * D + h * RDV);
        } else { const int i2 = it - NR; const int h = i2 % HH, n = (i2 / HH) % HN, b = i2 / (HH * HN); const size_t row0 = (size_t)b * T + n * HC;
            const bf16* base = F.PROJ + row0 * NIN;
            p5_item_naive<HC, HDV>(F, base + C_HQ + h * HDK, base + C_HF + h * HDK, base + C_HI + h * HDV, base + C_HG + h * HDV,
                                   F.HS + (((size_t)b * HN + n) * HH + h) * HDV * HDK, F.hg_norm_w + h * HDV, F.HB + row0 * D + RH * RDV + h * HDV);
        }
    }
    __syncthreads();
}

__device__ __forceinline__ void p7_final_ln(Frame& F) {
    const int gw = F.vcu * NWAVES + F.wave, NGW = F.G * NWAVES;
    for (int row = gw; row < M; row += NGW) {
        GAS f32x4* zr = (GAS f32x4*)(F.out + (size_t)row * D) + F.lane;
        f32x4 v[8]; float s = 0.f;
#pragma unroll
        for (int j = 0; j < 8; ++j) { v[j] = zr[64 * j]; s += (v[j].x + v[j].y) + (v[j].z + v[j].w); }
        const float mean = wave_sum(s) * (1.f / D); float s2 = 0.f;
#pragma unroll
        for (int j = 0; j < 8; ++j) { v[j] = v[j] - mean; s2 += (v[j].x * v[j].x + v[j].y * v[j].y) + (v[j].z * v[j].z + v[j].w * v[j].w); }
        const float rstd = 1.f / sqrtf(wave_sum(s2) * (1.f / D) + EPS);
#pragma unroll
        for (int j = 0; j < 8; ++j) { const int c0 = 4 * F.lane + 256 * j;
            const f32x4 w = *(const f32x4*)(F.ln_w + c0), bb = *(const f32x4*)(F.ln_b + c0);
            zr[64 * j] = v[j] * rstd * w + bb; }
    }
}

typedef short bf16x8 __attribute__((ext_vector_type(8)));
typedef short s16x4 __attribute__((ext_vector_type(4)));
typedef float f32x16 __attribute__((ext_vector_type(16)));
#define MFMA32(a, b, c) __builtin_amdgcn_mfma_f32_32x32x16_bf16((a), (b), (c), 0, 0, 0)
__device__ __forceinline__ int rimg(int row, int col) { return row * 256 + ((col * 2) ^ ((row & 15) << 4)); }
__device__ __forceinline__ int timg(int row, int col) { return row * 256 + ((col * 2) ^ ((row & 3) << 6)); }
__device__ __forceinline__ s16x4 ds_tr(const LAS unsigned char* p) { typedef short v4s __attribute__((ext_vector_type(4))); return __builtin_amdgcn_ds_read_tr16_b64_v4i16((LAS v4s*)p); }
__device__ __forceinline__ bf16x8 frag_tr(const LAS unsigned char* img, int k0, int c0, int lane) {
    const int h = lane >> 5, g1 = (lane >> 4) & 1, q = (lane >> 2) & 3, p = lane & 3;
    const s16x4 lo = ds_tr(img + timg(k0 + 8 * h + q, c0 + 16 * g1 + 4 * p));
    const s16x4 hi = ds_tr(img + timg(k0 + 8 * h + 4 + q, c0 + 16 * g1 + 4 * p));
    return __builtin_shufflevector(lo, hi, 0, 1, 2, 3, 4, 5, 6, 7);
}
template <int R, int NC, bool TR>
__device__ __forceinline__ void tile_to_lds(LAS unsigned char* img, const bf16* g, int pitch, int tid) {
    constexpr int PR = NC / 8;
#pragma unroll
    for (int idx0 = 0; idx0 < R * PR; idx0 += NTHR) { const int idx = idx0 + tid; const int row = idx / PR, c8 = idx % PR;
        const v4u t = *(const v4u*)(g + (size_t)row * pitch + c8 * 8);
        *(LAS v4u*)(img + (TR ? timg(row, c8 * 8) : rimg(row, c8 * 8))) = t; }
}

constexpr int P5_R0 = 0, P5_R1 = 32768, P5_R2 = 65536, P5_R3 = 98304, P5_RED = LDSCTL_OFF + 1024;
template <int C, int DV>
__device__ __forceinline__ void p5_item(Frame& F, const bf16* qt, const bf16* kt, const bf16* v, const bf16* g, const bf16* ST, const float* nw, bf16* mixed) {
    constexpr int NIB = C / 32, NEH = DV / 128;
    constexpr int NIW = NIB / 2;
    LAS unsigned char* R0 = F.lds + P5_R0; LAS unsigned char* R1 = F.lds + P5_R1; LAS unsigned char* R2 = F.lds + P5_R2; LAS unsigned char* R3 = F.lds + P5_R3;
    LAS float* RED = (LAS float*)(F.lds + P5_RED);
    const int lane = F.lane, w = F.wave, r = lane & 31, h = lane >> 5, t = w & 3, q = w >> 2;
    __syncthreads();
    tile_to_lds<C, 128, false>(R0, qt, NIN, F.tid);
    tile_to_lds<C, 128, false>(R1, kt, NIN, F.tid);
    tile_to_lds<C, 128, true>(R2, v, NIN, F.tid);
    bf16x8 sf[8];
#pragma unroll
    for (int s = 0; s < 8; ++s) sf[s] = *(const bf16x8*)(ST + (size_t)(32 * t + r) * 128 + 16 * s + 8 * h);
    __syncthreads();
    for (int blk = w; blk < NIB * NIB; blk += NWAVES) {
        const int ib = blk / NIB, jb = blk % NIB;
        if (jb > ib) continue;
        f32x16 X;
#pragma unroll
        for (int i = 0; i < 16; ++i) X[i] = 0.f;
#pragma unroll
        for (int s = 0; s < 8; ++s) {
            const bf16x8 a = *(const LAS bf16x8*)(R1 + rimg(jb * 32 + r, 16 * s + 8 * h));
            const bf16x8 b = *(const LAS bf16x8*)(R0 + rimg(ib * 32 + r, 16 * s + 8 * h));
            X = MFMA32(a, b, X);
        }
        if (jb == ib) {
#pragma unroll
            for (int rr = 0; rr < 16; ++rr) { const int j = (rr & 3) + 8 * (rr >> 2) + 4 * h; if (j > r) X[rr] = 0.f; }
        }
#pragma unroll
        for (int gq = 0; gq < 4; ++gq) { v2u pw; pw.x = pk2(X[4 * gq], X[4 * gq + 1]); pw.y = pk2(X[4 * gq + 2], X[4 * gq + 3]);
            *(LAS v2u*)(R3 + rimg(ib * 32 + r, jb * 32 + 8 * gq + 4 * h)) = pw; }
    }
    __syncthreads();
    v4u vh[(NEH == 2) ? (C * 16 / NTHR) : 1];
    if (NEH == 2) {
#pragma unroll
        for (int k = 0; k < C * 16 / NTHR; ++k) { const int idx = k * NTHR + F.tid; vh[k] = *(const v4u*)(v + (size_t)(idx / 16) * NIN + 128 + (idx % 16) * 8); }
    }
    f32x16 acc[NEH][NIW];
#pragma unroll
    for (int p = 0; p < NEH; ++p) {
        const LAS unsigned char* RV = (p == 0) ? R2 : R1;
        if (p == 1) {
#pragma unroll
            for (int k = 0; k < C * 16 / NTHR; ++k) { const int idx = k * NTHR + F.tid; *(LAS v4u*)(R1 + timg(idx / 16, (idx % 16) * 8)) = vh[k]; }
#pragma unroll
            for (int s = 0; s < 8; ++s) sf[s] = *(const bf16x8*)(ST + (size_t)(128 + 32 * t + r) * 128 + 16 * s + 8 * h);
            __syncthreads();
        }
#pragma unroll
        for (int iw = 0; iw < NIW; ++iw) {
            const int ib = q * NIW + iw;
            f32x16 a_;
#pragma unroll
            for (int i = 0; i < 16; ++i) a_[i] = 0.f;
            for (int jb = 0; jb <= ib; ++jb) {
#pragma unroll
                for (int s = 0; s < 2; ++s) {
                    const bf16x8 a = frag_tr(RV, jb * 32 + 16 * s, 32 * t, lane);
                    const bf16x8 b = *(const LAS bf16x8*)(R3 + rimg(ib * 32 + r, jb * 32 + 16 * s + 8 * h));
                    a_ = MFMA32(a, b, a_);
                }
            }
#pragma unroll
            for (int s = 0; s < 8; ++s) {
                const bf16x8 b = *(const LAS bf16x8*)(R0 + rimg(ib * 32 + r, 16 * s + 8 * h));
                a_ = MFMA32(sf[s], b, a_);
            }
            acc[p][iw] = a_;
        }
    }
    float ss[NIW];
#pragma unroll
    for (int iw = 0; iw < NIW; ++iw) { float s_ = 0.f;
#pragma unroll
        for (int p = 0; p < NEH; ++p)
#pragma unroll
            for (int i = 0; i < 16; ++i) s_ += acc[p][iw][i] * acc[p][iw][i];
        s_ += __shfl_xor(s_, 32);
        ss[iw] = s_; }
    if (h == 0) {
#pragma unroll
        for (int iw = 0; iw < NIW; ++iw) RED[w * 64 + iw * 32 + r] = ss[iw];
    }
    __syncthreads();
    float rstd[NIW];
#pragma unroll
    for (int iw = 0; iw < NIW; ++iw) { float s_ = 0.f;
#pragma unroll
        for (int tt = 0; tt < 4; ++tt) s_ += RED[(q * 4 + tt) * 64 + iw * 32 + r];
        rstd[iw] = 1.0f / sqrtf(s_ * (1.0f / DV) + EPS); }
#pragma unroll
    for (int p = 0; p < NEH; ++p)
#pragma unroll
        for (int iw = 0; iw < NIW; ++iw) { const int i = (q * NIW + iw) * 32 + r;
#pragma unroll
            for (int gq = 0; gq < 4; ++gq) { const int e = 128 * p + 32 * t + 8 * gq + 4 * h;
                const v2u gw = *(const v2u*)(g + (size_t)i * NIN + e);
                f32x4 o; o.x = acc[p][iw][4 * gq] * bflo(gw.x); o.y = acc[p][iw][4 * gq + 1] * bfhi(gw.x); o.z = acc[p][iw][4 * gq + 2] * bflo(gw.y); o.w = acc[p][iw][4 * gq + 3] * bfhi(gw.y);
                o = o * rstd[iw];
                if (nw) o = o * *(const f32x4*)(nw + e);
                v2u ow; ow.x = pk2(o.x, o.y); ow.y = pk2(o.z, o.w);
                *(v2u*)(mixed + (size_t)i * D + e) = ow; } }
}
__device__ __forceinline__ void p5_output(Frame& F) {
    constexpr int NR = BATCH * RN * RH, NHI = BATCH * HN * HH;
    for (int it = blockIdx.x; it < NR + NHI; it += F.G) {
        if (it < NR) { const int h = it % RH, n = (it / RH) % RN, b = it / (RH * RN); const size_t row0 = (size_t)b * T + n * RC;
            const bf16* base = F.PROJ + row0 * NIN;
            p5_item<RC, RDV>(F, base + C_RQ + h * RDK, base + C_RK + h * RDK, base + C_RV + h * RDV, base + C_RG + h * RDV,
                             F.RS + (((size_t)b * RN + n) * RH + h) * RDV * RDK, nullptr, F.HB + row0 * D + h * RDV);
        } else { const int i2 = it - NR; const int h = i2 % HH, n = (i2 / HH) % HN, b = i2 / (HH * HN); const size_t row0 = (size_t)b * T + n * HC;
            const bf16* base = F.PROJ + row0 * NIN;
            p5_item<HC, HDV>(F, base + C_HQ + h * HDK, base + C_HF + h * HDK, base + C_HI + h * HDV, base + C_HG + h * HDV,
                             F.HS + (((size_t)b * HN + n) * HH + h) * HDV * HDK, F.hg_norm_w + h * HDV, F.HB + row0 * D + RH * RDV + h * HDV);
        }
    }
    __syncthreads();
}

template <int C, int NCH, int DV, bool RET>
__device__ __forceinline__ void p4_unit(Frame& F, const bf16* kt, const bf16* v, bf16* ST, const float* lam, float cd) {
    constexpr size_t st_n = (size_t)(RET ? RH : HH) * DV * 128;
    constexpr int KP = C * 16 / NTHR, VP = C * 8 / NTHR;
    const int lane = F.lane, w = F.wave, r = lane & 31, h = lane >> 5, et = w & 1, dt = w >> 1;
    LAS unsigned char* buf[2] = {F.lds, F.lds + 65536};
    v4u kr[KP], vr[VP];
    f32x16 S;
#pragma unroll
    for (int i = 0; i < 16; ++i) S[i] = 0.f;
    __syncthreads();
#pragma unroll
    for (int k = 0; k < KP; ++k) { const int idx = k * NTHR + F.tid; *(LAS v4u*)(buf[0] + timg(idx / 16, (idx % 16) * 8)) = *(const v4u*)(kt + (size_t)(idx / 16) * NIN + (idx % 16) * 8); }
#pragma unroll
    for (int k = 0; k < VP; ++k) { const int idx = k * NTHR + F.tid; *(LAS v4u*)(buf[0] + 32768 + timg(idx / 8, (idx % 8) * 8)) = *(const v4u*)(v + (size_t)(idx / 8) * NIN + (idx % 8) * 8); }
    __syncthreads();
    for (int n = 0; n < NCH; ++n) {
        const LAS unsigned char* cb = buf[n & 1]; LAS unsigned char* nb = buf[(n + 1) & 1];
        if (n + 1 < NCH) {
            const bf16* ktn = kt + (size_t)(n + 1) * C * NIN; const bf16* vn = v + (size_t)(n + 1) * C * NIN;
#pragma unroll
            for (int k = 0; k < KP; ++k) { const int idx = k * NTHR + F.tid; kr[k] = *(const v4u*)(ktn + (size_t)(idx / 16) * NIN + (idx % 16) * 8); }
#pragma unroll
            for (int k = 0; k < VP; ++k) { const int idx = k * NTHR + F.tid; vr[k] = *(const v4u*)(vn + (size_t)(idx / 8) * NIN + (idx % 8) * 8); }
        }
        bf16* stp = ST + (size_t)n * st_n + (size_t)(32 * et + r) * 128 + 32 * dt + 4 * h;
#pragma unroll
        for (int gq = 0; gq < 4; ++gq) { v2u pw; pw.x = pk2(S[4 * gq], S[4 * gq + 1]); pw.y = pk2(S[4 * gq + 2], S[4 * gq + 3]); *(v2u*)(stp + 8 * gq) = pw; }
#pragma unroll
        for (int s = 0; s < C / 16; ++s) {
            const bf16x8 a = frag_tr(cb, 16 * s, 32 * dt, lane);
            const bf16x8 b = frag_tr(cb + 32768, 16 * s, 32 * et, lane);
            S = MFMA32(a, b, S);
        }
        if (RET) {
#pragma unroll
            for (int i = 0; i < 16; ++i) S[i] *= cd;
        } else {
            const float* lp = lam + (size_t)n * (HH * HDK) + 32 * dt + 4 * h;
#pragma unroll
            for (int gq = 0; gq < 4; ++gq) { const f32x4 l4 = *(const f32x4*)(lp + 8 * gq);
                S[4 * gq] *= l4.x; S[4 * gq + 1] *= l4.y; S[4 * gq + 2] *= l4.z; S[4 * gq + 3] *= l4.w; }
        }
        if (n + 1 < NCH) {
#pragma unroll
            for (int k = 0; k < KP; ++k) { const int idx = k * NTHR + F.tid; *(LAS v4u*)(nb + timg(idx / 16, (idx % 16) * 8)) = kr[k]; }
#pragma unroll
            for (int k = 0; k < VP; ++k) { const int idx = k * NTHR + F.tid; *(LAS v4u*)(nb + 32768 + timg(idx / 8, (idx % 8) * 8)) = vr[k]; }
        }
        __syncthreads();
    }
}
__device__ __forceinline__ void p4_state(Frame& F) {
    constexpr int NRU = BATCH * RH * (RDV / 64), NHU = BATCH * HH * (HDV / 64);
    for (int it = blockIdx.x; it < NRU + NHU; it += F.G) {
        if (it < NRU) { const int es = it % 4, h = (it / 4) % RH, b = it / (4 * RH);
            const bf16* base = F.PROJ + (size_t)b * T * NIN;
            p4_unit<RC, RN, RDV, true>(F, base + C_RK + h * RDK, base + C_RV + h * RDV + 64 * es, F.RS + (((size_t)b * RN) * RH + h) * RDV * RDK + (size_t)(64 * es) * 128, nullptr,
                                       exp2f((float)RC * ret_log2_gamma(h)));
        } else { const int i2 = it - NRU; const int es = i2 % 2, h = (i2 / 2) % HH, b = i2 / (2 * HH);
            const bf16* base = F.PROJ + (size_t)b * T * NIN;
            p4_unit<HC, HN, HDV, false>(F, base + C_HF + h * HDK, base + C_HI + h * HDV + 64 * es, F.HS + (((size_t)b * HN) * HH + h) * HDV * HDK + (size_t)(64 * es) * 128,
                                        F.LAM + ((size_t)b * HN * HH + h) * HDK, 1.0f);
        }
    }
    __syncthreads();
}

struct Args { const void* in[11]; float* out; unsigned char* ws; int ph_lo, ph_hi, li, pad; };
__global__ void __launch_bounds__(NTHR, 2) hymba_fwd(Args args) {
    extern __shared__ __attribute__((aligned(16))) unsigned char lds[];
    Frame F;
    F.lds = (LAS unsigned char*)lds;
    F.MISC = (volatile LAS unsigned*)(F.lds + MISC_OFF);
    F.tid = threadIdx.x; F.lane = F.tid & 63; F.wave = __builtin_amdgcn_readfirstlane(F.tid >> 6);
    F.G = gridDim.x; { const int bx = blockIdx.x; F.vcu = (F.G % 8 == 0) ? (bx % 8) * (F.G / 8) + bx / 8 : bx; }
    unsigned char* ws = args.ws;
    F.ctl = (gu32*)(ws + WS_CTL);
    F.x = (const float*)args.in[0]; F.c = (const float*)args.in[1]; F.positions = (const int*)args.in[2]; F.w_ada = (const float*)args.in[3]; F.b_ada = (const float*)args.in[4];
    F.w_in = (const float*)args.in[5]; F.lb_logits = (const float*)args.in[6]; F.hg_norm_w = (const float*)args.in[7]; F.w_out = (const float*)args.in[8];
    F.ln_w = (const float*)args.in[9]; F.ln_b = (const float*)args.in[10]; F.out = args.out;
    F.LB = (float*)(ws + WS_LB); F.GATE = (float*)(ws + WS_GATE); F.LAM = (float*)(ws + WS_LAM); F.MODP = (float*)(ws + WS_MODP); F.ROPE = (float*)(ws + WS_ROPE);
    F.WIN = (bf16*)(ws + WS_WIN); F.WOUT = (bf16*)(ws + WS_WOUT); F.HB = (bf16*)(ws + WS_H); F.PROJ = (bf16*)(ws + WS_PROJ); F.RS = (bf16*)(ws + WS_RS); F.HS = (bf16*)(ws + WS_HS);
    for (int u = F.tid; u < (LDS_BYTES - LDSCTL_OFF) / 4; u += NTHR) ((LAS unsigned*)(F.lds + LDSCTL_OFF))[u] = 0u;
    __syncthreads();
    XcdBarrier bar; bar.bar = (unsigned*)(F.ctl + CW_BAR); bar.x = 0; bar.st = nullptr;
    if (N_LAUNCHES != NPHASE) bar = xcd_barrier_post((unsigned*)(F.ctl + CW_BAR), F.MISC + 8);
#define GRID_BAR() do { if (N_LAUNCHES != NPHASE) xcd_barrier(bar); } while (0)
    const int lo = args.ph_lo, hi = args.ph_hi;
#define IN(k) (lo <= (k) && (k) < hi)
#define BOTH(k) (IN(k) && IN((k) + 1))

    if (IN(0)) { p0_prologue(F); if (BOTH(0)) GRID_BAR(); }
    if (IN(1)) { p1_modulate(F); if (BOTH(1)) GRID_BAR(); }
    if (IN(2)) {
        pg8::Gemm g{F.HB, F.WIN, M, NIN, D}; pg8::StaticOrder S; S.init(M, NIN, F.G, (int)blockIdx.x);
#if defined(NAIVE_P3)
        pg8::EpiProj E{F.PROJ, NIN};
        pg8::gemm_phase<pg8::EpiProj, pg8::StaticOrder, true, true>(F.lds + RING_OFF, g, S, E);
#else
        pg8::EpiFused E{F.PROJ, NIN, F.ROPE, F.LB, F.LAM, ret_log2_gamma(0), ret_log2_gamma(1), ret_log2_gamma(2), ret_log2_gamma(3)};
        pg8::gemm_phase<pg8::EpiFused, pg8::StaticOrder, true, true>(F.lds + RING_OFF, g, S, E);
#endif
        if (BOTH(2)) GRID_BAR();
    }
#if defined(NAIVE_P3)
    if (IN(3)) { p3_transform_naive(F); if (BOTH(3)) GRID_BAR(); }
#endif
    #if defined(NAIVE_P4)
    if (IN(4)) { p4_state_naive(F); if (BOTH(4)) GRID_BAR(); }
#else
    if (IN(4)) { p4_state(F); if (BOTH(4)) GRID_BAR(); }
#endif
    #if defined(NAIVE_P5)
    if (IN(5)) { p5_output_naive(F); if (BOTH(5)) GRID_BAR(); }
#else
    if (IN(5)) { p5_output(F); if (BOTH(5)) GRID_BAR(); }
#endif
    if (IN(6)) {
        pg8::Gemm g{F.HB, F.WOUT, M, D, D}; pg8::StaticOrder S; S.init(M, D, F.G, (int)blockIdx.x);
        pg8::EpiZ E{F.x, F.out, D, F.GATE, T, ALPHA};
        pg8::gemm_phase<pg8::EpiZ, pg8::StaticOrder, true, true>(F.lds + RING_OFF, g, S, E);
        if (BOTH(6)) GRID_BAR();
    }
    if (IN(7)) { p7_final_ln(F); }
#undef IN
#undef BOTH
}

extern "C" void kernel_launch(void* const* d_in, const int* in_sizes, int n_in, void* d_out, int out_size, void* d_ws, size_t ws_size, hipStream_t stream) {
    static int grid = 0;
    if (grid == 0) {
        if (n_in != 11 || in_sizes[0] != M * D || out_size != M * D || ws_size < WS_END) { fprintf(stderr, "kernel_launch: unexpected shapes: n_in %d in0 %d out %d ws %zu (need %zu)\n", n_in, n_in > 0 ? in_sizes[0] : -1, out_size, ws_size, (size_t)WS_END); grid = -1; return; }
        int dev = 0, cus = 0, per_cu = 0;
        if (hipGetDevice(&dev) != hipSuccess || hipDeviceGetAttribute(&cus, hipDeviceAttributeMultiprocessorCount, dev) != hipSuccess) { fprintf(stderr, "kernel_launch: device query failed\n"); grid = -1; return; }
        if (hipFuncSetAttribute((const void*)hymba_fwd, hipFuncAttributeMaxDynamicSharedMemorySize, LDS_BYTES) != hipSuccess) { fprintf(stderr, "kernel_launch: hipFuncSetAttribute failed\n"); grid = -1; return; }
        if (hipOccupancyMaxActiveBlocksPerMultiprocessor(&per_cu, (const void*)hymba_fwd, NTHR, LDS_BYTES) != hipSuccess || per_cu < 1) { fprintf(stderr, "kernel_launch: occupancy query says %d workgroups per CU\n", per_cu); }
        (void)hipGetLastError();
        grid = cus;
    }
    if (grid < 0) return;
    if (hipMemsetAsync((char*)d_ws + WS_CTL, 0, CTL_ZERO_BYTES, stream) != hipSuccess) { fprintf(stderr, "kernel_launch: memset failed\n"); return; }
    Args a{};
    for (int i = 0; i < 11; ++i) a.in[i] = d_in[i];
    a.out = (float*)d_out; a.ws = (unsigned char*)d_ws;
    for (int li = 0; li < N_LAUNCHES; ++li) {
        a.ph_lo = (N_LAUNCHES == NPHASE) ? li : 0; a.ph_hi = (N_LAUNCHES == NPHASE) ? li + 1 : NPHASE; a.li = li;
        hipLaunchKernelGGL(hymba_fwd, dim3(grid), dim3(NTHR), LDS_BYTES, stream, a);
        const hipError_t le = hipPeekAtLastError();
        if (le != hipSuccess) { fprintf(stderr, "kernel_launch: launch %d failed: %s\n", li, hipGetErrorName(le)); break; }
    }
}
```

```cpp
#include <hip/hip_runtime.h>
#include <cstdio>
#include <cstdint>
namespace pg8 {
#define PG8_LAS __attribute__((address_space(3)))
typedef unsigned short bf16_t;
typedef short bf16x8 __attribute__((ext_vector_type(8)));
typedef float f32x4 __attribute__((ext_vector_type(4)));
typedef unsigned u32x4 __attribute__((ext_vector_type(4)));
constexpr int BM = 256, BK = 64, HALF = 128, HTB = HALF * BK * 2  , STAGE_BYTES = 8 * HTB, NXCD = 8, WGM = 8;

__host__ __device__ __forceinline__ int lds_byte(int r, int c) { const int st = (r >> 4) * 2 + (c >> 5), rr = r & 15, cc = c & 31, ob = rr * 64 + cc * 2; return st * 1024 + (ob ^ (((ob >> 9) & 1) << 5)); }
__host__ __device__ __forceinline__ void stage_rc(int b, int& R, int& C) { const int st = b / 1024, sb = b % 1024, swz = sb ^ (((sb >> 9) & 1) << 5); R = (st >> 1) * 16 + swz / 64; C = (st & 1) * 32 + (swz % 64) / 2; }
__host__ __device__ __forceinline__ int perm32(int rho) { const int n = rho >> 4, i = rho & 15; return 8 * (i >> 2) + 4 * n + (i & 3); }

struct Unit { int pm, pn; };
struct Gemm { const bf16_t* A; const bf16_t* Bt; int M, N, K; };

struct StaticOrder {
    int nM, nN, nwg, G, c;
    __host__ __device__ void init(int M, int N, int G_, int c_) { nM = M / BM; nN = N / BM; nwg = nM * nN; G = G_; c = c_; }
    __host__ __device__ bool next(int i, Unit& u) const {
        const long L = (long)i * G + c; if (L >= nwg) return false;
        int wgid = (int)L; { const int q = nwg / NXCD, r = nwg % NXCD, xcd = wgid % NXCD, off = wgid / NXCD; wgid = (xcd < r ? xcd * (q + 1) : r * (q + 1) + (xcd - r) * q) + off; }
        const int nig = WGM * nN, gid = wgid / nig, fm = gid * WGM, gsz = (nM - fm) < WGM ? (nM - fm) : WGM;
        u.pm = fm + ((wgid % nig) % gsz); u.pn = (wgid % nig) / gsz; return true;
    }
    __device__ __forceinline__ void a_ready(const Unit&) const {}
    __device__ __forceinline__ void done(const Unit&) const {}
};

__device__ __forceinline__ unsigned cvt_pk_bf16(float lo, float hi) { unsigned r; asm volatile("v_cvt_pk_bf16_f32 %0, %1, %2" : "=v"(r) : "v"(lo), "v"(hi)); return r; }
struct EpiProj {
    static constexpr bool PERM = true, AFTER_DRAIN = false;
    bf16_t* O; int ldc;
    __device__ __forceinline__ void operator()(const f32x4 (&acc)[2][2][4][2], const Unit& u, int wr, int wc, int fr, int fq) const {
        const int row0 = u.pm * BM + wr * 64 + fr, col0 = u.pn * BM + wc * 32 + 8 * fq;
#pragma unroll
        for (int ai = 0; ai < 2; ++ai)
#pragma unroll
            for (int m = 0; m < 4; ++m) { bf16_t* rowp = O + (size_t)(row0 + ai * HALF + m * 16) * ldc + col0;
#pragma unroll
                for (int bj = 0; bj < 2; ++bj) { const f32x4 v0 = acc[ai][bj][m][0], v1 = acc[ai][bj][m][1];
                    u32x4 w; w.x = cvt_pk_bf16(v0[0], v0[1]); w.y = cvt_pk_bf16(v0[2], v0[3]); w.z = cvt_pk_bf16(v1[0], v1[1]); w.w = cvt_pk_bf16(v1[2], v1[3]);
                    *(u32x4*)(rowp + bj * HALF) = w; } }
    }
};
struct EpiZ {
    static constexpr bool PERM = false, AFTER_DRAIN = false;
    const float* X; float* Z; int ldc; const float* gate; int rows_per_batch; float alpha;
    __device__ __forceinline__ void operator()(const f32x4 (&acc)[2][2][4][2], const Unit& u, int wr, int wc, int fr, int fq) const {
        const int row0 = u.pm * BM + wr * 64 + fr, col0 = u.pn * BM + wc * 32 + 4 * fq;
        const float* g = gate + (size_t)((u.pm * BM) / rows_per_batch) * ldc + col0;
        f32x4 gv[2][2];
#pragma unroll
        for (int bj = 0; bj < 2; ++bj)
#pragma unroll
            for (int n = 0; n < 2; ++n) gv[bj][n] = *(const f32x4*)(g + bj * HALF + n * 16);
#pragma unroll
        for (int ai = 0; ai < 2; ++ai)
#pragma unroll
            for (int m = 0; m < 4; ++m) { const size_t off = (size_t)(row0 + ai * HALF + m * 16) * ldc + col0;
#pragma unroll
                for (int bj = 0; bj < 2; ++bj)
#pragma unroll
                    for (int n = 0; n < 2; ++n) { const f32x4 xv = *(const f32x4*)(X + off + bj * HALF + n * 16);
                        *(f32x4*)(Z + off + bj * HALF + n * 16) = xv * alpha + gv[bj][n] * acc[ai][bj][m][n]; }
                if (m == 3) asm volatile("" ::: "memory"); }
    }
};
__device__ __forceinline__ float epi_sigmoid(float x) { return 1.0f / (1.0f + __expf(-x)); }
struct EpiFused {
    static constexpr bool PERM = false, AFTER_DRAIN = false;
    bf16_t* O; int ldc;
    const float* rope;
    const float* lbv;
    float* lam;
    float lg2_0, lg2_1, lg2_2, lg2_3;
    __device__ __forceinline__ void operator()(const f32x4 (&acc)[2][2][4][2], const Unit& u, int wr, int wc, int fr, int fq) const {
        const int pn = u.pn, rowb = u.pm * BM + wr * 64 + fr;
        if (pn < 4) {
            const int head = 2 * (pn & 1) + (wc >> 1), i0 = 32 * (wc & 1) + 8 * fq, colb = (pn < 2 ? 0 : 512) + head * 128 + i0;
            const float lgh = head == 0 ? lg2_0 : (head == 1 ? lg2_1 : (head == 2 ? lg2_2 : lg2_3)); const float lgs = (pn < 2) ? lgh : -lgh;
#pragma unroll
            for (int ai = 0; ai < 2; ++ai)
#pragma unroll
                for (int m = 0; m < 4; ++m) { const int row = rowb + ai * HALF + m * 16; const int tl = row & 127;
                    const float sc = exp2f((float)(tl + 1) * lgs);
                    const float* rp = rope + (size_t)row * 128 + i0;
                    const f32x4 c0 = *(const f32x4*)(rp), c1 = *(const f32x4*)(rp + 4), s0 = *(const f32x4*)(rp + 64), s1 = *(const f32x4*)(rp + 68);
                    const f32x4 a0 = acc[ai][0][m][0], a1 = acc[ai][0][m][1], b0 = acc[ai][1][m][0], b1 = acc[ai][1][m][1];
                    const f32x4 o10 = (a0 * c0 - b0 * s0) * sc, o11 = (a1 * c1 - b1 * s1) * sc, o20 = (a0 * s0 + b0 * c0) * sc, o21 = (a1 * s1 + b1 * c1) * sc;
                    bf16_t* rowp = O + (size_t)row * ldc + colb;
                    u32x4 w1; w1.x = cvt_pk_bf16(o10[0], o10[1]); w1.y = cvt_pk_bf16(o10[2], o10[3]); w1.z = cvt_pk_bf16(o11[0], o11[1]); w1.w = cvt_pk_bf16(o11[2], o11[3]);
                    u32x4 w2; w2.x = cvt_pk_bf16(o20[0], o20[1]); w2.y = cvt_pk_bf16(o20[2], o20[3]); w2.z = cvt_pk_bf16(o21[0], o21[1]); w2.w = cvt_pk_bf16(o21[2], o21[3]);
                    *(u32x4*)(rowp) = w1; *(u32x4*)(rowp + 64) = w2; }
        } else if (pn >= 12 && pn < 20) {
            const int h = pn - 12, d0 = 32 * wc + 8 * fq;
            const f32x4 lb0 = *(const f32x4*)(lbv + h * 128 + d0), lb1 = *(const f32x4*)(lbv + h * 128 + d0 + 4);
#pragma unroll
            for (int ai = 0; ai < 2; ++ai) {
                const int row0 = u.pm * BM + ai * HALF + wr * 64;
                float carry[2][4];
#pragma unroll
                for (int n = 0; n < 2; ++n)
#pragma unroll
                    for (int j = 0; j < 4; ++j) carry[n][j] = 0.f;
#pragma unroll
                for (int m = 0; m < 4; ++m) {
                    float qo[2][4], ko[2][4];
#pragma unroll
                    for (int n = 0; n < 2; ++n)
#pragma unroll
                        for (int j = 0; j < 4; ++j) {
                            const float lb = n ? lb1[j] : lb0[j];
                            const float fp = acc[ai][1][m][n][j], q = acc[ai][0][m][n][j];
                            const float e = __expf(-fp), sg = 1.0f / (1.0f + e), sgn = e * sg;
                            const float f = lb + (1.0f - lb) * sg;
                            float g = __logf(f);
#pragma unroll
                            for (int dlt = 1; dlt < 16; dlt <<= 1) { const float t = __shfl_up(g, dlt, 16); if (fr >= dlt) g += t; }
                            const float tot = __shfl(g, 15, 16);
                            const float b = carry[n][j] + g; carry[n][j] += tot;
                            const float eb = __expf(b);
                            qo[n][j] = q * eb; ko[n][j] = (1.0f - lb) * sgn / eb;
                        }
                    bf16_t* rowp = O + (size_t)(row0 + 16 * m + fr) * ldc + 3072 + h * 128 + d0;
                    u32x4 wq; wq.x = cvt_pk_bf16(qo[0][0], qo[0][1]); wq.y = cvt_pk_bf16(qo[0][2], qo[0][3]); wq.z = cvt_pk_bf16(qo[1][0], qo[1][1]); wq.w = cvt_pk_bf16(qo[1][2], qo[1][3]);
                    u32x4 wk; wk.x = cvt_pk_bf16(ko[0][0], ko[0][1]); wk.y = cvt_pk_bf16(ko[0][2], ko[0][3]); wk.z = cvt_pk_bf16(ko[1][0], ko[1][1]); wk.w = cvt_pk_bf16(ko[1][2], ko[1][3]);
                    *(u32x4*)(rowp) = wq; *(u32x4*)(rowp + 1024) = wk;
                    asm volatile("" ::: "memory");
                }
                if (fr == 15) {
                    const int bidx = row0 >> 11, chunk = (row0 & 2047) >> 6;
                    float* lp = lam + (((size_t)bidx * 32 + chunk) * 8 + h) * 128 + d0;
                    f32x4 l0, l1;
#pragma unroll
                    for (int j = 0; j < 4; ++j) { l0[j] = __expf(carry[0][j]); l1[j] = __expf(carry[1][j]); }
                    *(f32x4*)(lp) = l0; *(f32x4*)(lp + 4) = l1;
                }
            }
        } else {
            const bool act = (pn >= 8 && pn < 12) || pn >= 24;
            const int col0 = pn * BM + wc * 32 + 8 * fq;
#pragma unroll
            for (int ai = 0; ai < 2; ++ai)
#pragma unroll
                for (int m = 0; m < 4; ++m) { bf16_t* rowp = O + (size_t)(rowb + ai * HALF + m * 16) * ldc + col0;
#pragma unroll
                    for (int bj = 0; bj < 2; ++bj) { f32x4 v0 = acc[ai][bj][m][0], v1 = acc[ai][bj][m][1];
                        if (act) {
#pragma unroll
                            for (int j = 0; j < 4; ++j) { v0[j] = v0[j] * epi_sigmoid(v0[j]); v1[j] = v1[j] * epi_sigmoid(v1[j]); } }
                        u32x4 w; w.x = cvt_pk_bf16(v0[0], v0[1]); w.y = cvt_pk_bf16(v0[2], v0[3]); w.z = cvt_pk_bf16(v1[0], v1[1]); w.w = cvt_pk_bf16(v1[2], v1[3]);
                        *(u32x4*)(rowp + bj * HALF) = w; } }
        }
    }
};
template <class Epi, class Sched, bool ALIGN_EPI = false, bool SP2 = false>
__device__ __forceinline__ void gemm_phase(PG8_LAS unsigned char* lds, const Gemm g, const Sched& S, const Epi& E) {
    const int tid = threadIdx.x, wid = __builtin_amdgcn_readfirstlane(tid >> 6), lane = tid & 63, wr = wid >> 2, wc = wid & 3, fr = lane & 15, fq = lane >> 4;
    const int K = g.K, nt = K / BK;
    unsigned voffA[2], voffB[2];
#pragma unroll
    for (int i = 0; i < 2; ++i) { int R, C; stage_rc(tid * 16 + i * 8192, R, C); const int Rb = Epi::PERM ? ((R & ~31) + perm32(R & 31)) : R;
        voffA[i] = (unsigned)(R * K + C) * 2u; voffB[i] = (unsigned)(Rb * K + C) * 2u; }
    const size_t kstep = (size_t)(BK * 2);
    const size_t hstep = (size_t)HALF * K * 2;
    const size_t tstep = 2 * hstep;
    const unsigned ldsw = (unsigned)wid * 1024u;
    const int aoff = lds_byte(wr * 64 + fr, fq * 8), boff = lds_byte(wc * 32 + fr, fq * 8);
#define PG8_SA(b, h) (((b) * 2 + (h)) * HTB)
#define PG8_SB(b, h) ((4 + (b) * 2 + (h)) * HTB)
#define PG8_STAGE(bufoff, gbase, voff) do { _Pragma("unroll") for (int _i = 0; _i < 2; ++_i) \
        __builtin_amdgcn_global_load_lds((const unsigned*)((const char*)(gbase) + (voff)[_i]), (PG8_LAS unsigned*)(lds + (bufoff) + ldsw + _i * 8192), 16, 0, 0); } while (0)
#define PG8_LDA(dst, b, h) do { _Pragma("unroll") for (int m = 0; m < 4; ++m) _Pragma("unroll") for (int k = 0; k < 2; ++k) dst[m][k] = *(const PG8_LAS bf16x8*)(lds + PG8_SA(b, h) + aoff + m * 2048 + k * 1024); } while (0)
#define PG8_LDB(dst, b, h) do { _Pragma("unroll") for (int n = 0; n < 2; ++n) _Pragma("unroll") for (int k = 0; k < 2; ++k) dst[n][k] = *(const PG8_LAS bf16x8*)(lds + PG8_SB(b, h) + boff + n * 2048 + k * 1024); } while (0)
#define PG8_MMA(ai, bj, At, Bt) do { __builtin_amdgcn_s_setprio(1); _Pragma("unroll") for (int m = 0; m < 4; ++m) _Pragma("unroll") for (int n = 0; n < 2; ++n) _Pragma("unroll") for (int k = 0; k < 2; ++k) \
        acc[ai][bj][m][n] = __builtin_amdgcn_mfma_f32_16x16x32_bf16(Bt[n][k], At[m][k], acc[ai][bj][m][n], 0, 0, 0); __builtin_amdgcn_s_setprio(0); } while (0)
#define PG8_WAIT_V(n) asm volatile("s_waitcnt vmcnt(" #n ")" ::: "memory")
#define PG8_WAIT_L(n) asm volatile("s_waitcnt lgkmcnt(" #n ")" ::: "memory")
#define PG8_BAR __builtin_amdgcn_s_barrier()
#define PG8_SCHED __builtin_amdgcn_sched_barrier(0)
    Unit cur, nxt; int ui = 0;
    if (!S.next(0, cur)) return;
    f32x4 acc[2][2][4][2];
#pragma unroll
    for (int a = 0; a < 2; ++a)
#pragma unroll
        for (int b = 0; b < 2; ++b)
#pragma unroll
            for (int m = 0; m < 4; ++m)
#pragma unroll
                for (int n = 0; n < 2; ++n) acc[a][b][m][n] = (f32x4){0.f, 0.f, 0.f, 0.f};
    bf16x8 At[4][2], B0[2][2], B1[2][2];
    const char* cA = (const char*)g.A + (size_t)cur.pm * tstep; const char* cB = (const char*)g.Bt + (size_t)cur.pn * tstep;
    S.a_ready(cur);
    if constexpr (SP2) {
        PG8_STAGE(PG8_SB(0, 0), cB, voffB); PG8_STAGE(PG8_SB(0, 1), cB + hstep, voffB); PG8_STAGE(PG8_SA(0, 0), cA, voffA); PG8_STAGE(PG8_SA(0, 1), cA + hstep, voffA);
        if (wr == 1) PG8_BAR;
        PG8_WAIT_V(2); PG8_BAR;
        PG8_STAGE(PG8_SB(1, 0), cB + kstep, voffB); PG8_STAGE(PG8_SA(1, 0), cA + kstep, voffA); PG8_STAGE(PG8_SB(1, 1), cB + hstep + kstep, voffB);
        PG8_WAIT_V(6); PG8_BAR;
    } else {
        PG8_STAGE(PG8_SB(0, 0), cB, voffB); PG8_STAGE(PG8_SA(0, 0), cA, voffA); PG8_STAGE(PG8_SB(0, 1), cB + hstep, voffB); PG8_STAGE(PG8_SA(0, 1), cA + hstep, voffA);
        if (wr == 1) PG8_BAR;
        PG8_WAIT_V(4); PG8_BAR;
        PG8_STAGE(PG8_SB(1, 0), cB + kstep, voffB); PG8_STAGE(PG8_SA(1, 0), cA + kstep, voffA); PG8_STAGE(PG8_SB(1, 1), cB + hstep + kstep, voffB);
        PG8_WAIT_V(6); PG8_BAR;
    }
    for (;;) {
        const bool has_next = S.next(ui + 1, nxt);
        const char* nA = has_next ? (const char*)g.A + (size_t)nxt.pm * tstep : cA; const char* nB = has_next ? (const char*)g.Bt + (size_t)nxt.pn * tstep : cB;
        for (int t = 0; t < nt; t += 2) {
            const bool last = (t == nt - 2);
            const char* a1 = cA + (size_t)(t + 1) * kstep;
            const char* a2 = last ? nA : cA + (size_t)(t + 2) * kstep; const char* b2 = last ? nB : cB + (size_t)(t + 2) * kstep;
            const char* a3 = a2 + kstep; const char* b3 = b2 + kstep;
            if (last && has_next) S.a_ready(nxt);
            if constexpr (SP2) {
            PG8_LDB(B0, 0, 0); PG8_LDB(B1, 0, 1); PG8_SCHED; PG8_LDA(At, 0, 0); PG8_STAGE(PG8_SA(1, 1), a1 + hstep, voffA);
            PG8_WAIT_V(8); PG8_WAIT_L(0); PG8_BAR; PG8_MMA(0, 0, At, B0); PG8_MMA(0, 1, At, B1); PG8_BAR; PG8_SCHED;
            PG8_LDA(At, 0, 1); PG8_STAGE(PG8_SB(0, 0), b2, voffB); PG8_STAGE(PG8_SB(0, 1), b2 + hstep, voffB); PG8_STAGE(PG8_SA(0, 0), a2, voffA);
            PG8_WAIT_V(8); PG8_WAIT_L(0); PG8_BAR; PG8_MMA(1, 0, At, B0); PG8_MMA(1, 1, At, B1); PG8_BAR; PG8_SCHED;
            PG8_LDB(B0, 1, 0); PG8_LDB(B1, 1, 1); PG8_SCHED; PG8_LDA(At, 1, 0); PG8_STAGE(PG8_SA(0, 1), a2 + hstep, voffA);
            PG8_WAIT_V(8); PG8_WAIT_L(0); PG8_BAR; PG8_MMA(0, 0, At, B0); PG8_MMA(0, 1, At, B1); PG8_BAR; PG8_SCHED;
            PG8_LDA(At, 1, 1); PG8_STAGE(PG8_SB(1, 0), b3, voffB); PG8_STAGE(PG8_SB(1, 1), b3 + hstep, voffB); PG8_STAGE(PG8_SA(1, 0), a3, voffA);
            PG8_WAIT_V(8); PG8_WAIT_L(0); PG8_BAR; PG8_MMA(1, 0, At, B0); PG8_MMA(1, 1, At, B1); PG8_BAR; PG8_SCHED;
            } else {
            PG8_LDB(B0, 0, 0); PG8_SCHED; PG8_LDA(At, 0, 0); PG8_STAGE(PG8_SA(1, 1), a1 + hstep, voffA);
            PG8_WAIT_L(8); PG8_BAR; PG8_WAIT_L(0); PG8_MMA(0, 0, At, B0); PG8_BAR; PG8_SCHED;
            PG8_LDB(B1, 0, 1); PG8_STAGE(PG8_SB(0, 0), b2, voffB);
            PG8_BAR; PG8_WAIT_L(0); PG8_MMA(0, 1, At, B1); PG8_BAR;
            PG8_LDA(At, 0, 1); PG8_STAGE(PG8_SA(0, 0), a2, voffA);
            PG8_BAR; PG8_WAIT_L(0); PG8_MMA(1, 0, At, B0); PG8_BAR; PG8_SCHED;
            PG8_STAGE(PG8_SB(0, 1), b2 + hstep, voffB);
            PG8_WAIT_V(6); PG8_BAR; PG8_MMA(1, 1, At, B1); PG8_BAR;
            PG8_LDB(B0, 1, 0); PG8_SCHED; PG8_LDA(At, 1, 0); PG8_STAGE(PG8_SA(0, 1), a2 + hstep, voffA);
            PG8_WAIT_L(8); PG8_BAR; PG8_WAIT_L(0); PG8_MMA(0, 0, At, B0); PG8_BAR; PG8_SCHED;
            PG8_LDB(B1, 1, 1); PG8_STAGE(PG8_SB(1, 0), b3, voffB);
            PG8_BAR; PG8_WAIT_L(0); PG8_MMA(0, 1, At, B1); PG8_BAR;
            PG8_LDA(At, 1, 1); PG8_STAGE(PG8_SA(1, 0), a3, voffA);
            PG8_BAR; PG8_WAIT_L(0); PG8_MMA(1, 0, At, B0); PG8_BAR; PG8_SCHED;
            PG8_STAGE(PG8_SB(1, 1), b3 + hstep, voffB);
            PG8_WAIT_V(6); PG8_BAR; PG8_MMA(1, 1, At, B1); PG8_BAR;
            }
        }
        if constexpr (ALIGN_EPI) { if (wr == 0) PG8_BAR; }
        if constexpr (!Epi::AFTER_DRAIN) { E(acc, cur, wr, wc, fr, fq); S.done(cur); }
        if (!has_next) break;
#pragma unroll
        for (int a = 0; a < 2; ++a)
#pragma unroll
            for (int b = 0; b < 2; ++b)
#pragma unroll
                for (int m = 0; m < 4; ++m)
#pragma unroll
                    for (int n = 0; n < 2; ++n) acc[a][b][m][n] = (f32x4){0.f, 0.f, 0.f, 0.f};
        cur = nxt; cA = nA; cB = nB; ++ui;
        if constexpr (ALIGN_EPI) { if (wr == 1) PG8_BAR; }
    }
    PG8_WAIT_V(0);
    if constexpr (!ALIGN_EPI) { if (wr == 0) PG8_BAR; }
    PG8_BAR;
    if constexpr (Epi::AFTER_DRAIN) { E.fused(acc, cur, wr, wc, fr, fq, lds, wid, lane); S.done(cur); }
#undef PG8_SA
#undef PG8_SB
#undef PG8_STAGE
#undef PG8_LDA
#undef PG8_LDB
#undef PG8_MMA
#undef PG8_WAIT_V
#undef PG8_WAIT_L
#undef PG8_BAR
#undef PG8_SCHED
}
}

constexpr int NWAVES = 8, NTHR = NWAVES * 64;
constexpr int BATCH = 8, T = 2048, D = 2048, M = BATCH * T, NIN = 7168, NMOD = 3 * D;
constexpr int RH = 4, RDK = 128, RDV = 256, RC = 128, RN = T / RC;
constexpr int HH = 8, HDK = 128, HDV = 128, HC = 64, HN = T / HC;
constexpr int C_RQ = 0, C_RK = 512, C_RV = 1024, C_RG = 2048, C_HQ = 3072, C_HF = 4096, C_HI = 5120, C_HG = 6144;
constexpr float EPS = 1e-6f;
constexpr float ALPHA = 1.189207115002721f;
constexpr int MOD_KS = 4;
#ifndef MK_N_LAUNCHES
#define MK_N_LAUNCHES 1
#endif
constexpr int NPHASE = 8;
constexpr int N_LAUNCHES = MK_N_LAUNCHES;

constexpr size_t MiB = 1u << 20;
constexpr size_t WS_CTL = 0, CTL_ZERO_BYTES = 64 * 1024;
constexpr size_t WS_LB = 1 * MiB;
constexpr size_t WS_GATE = WS_LB + 64 * 1024;
constexpr size_t WS_LAM = 2 * MiB;
constexpr size_t WS_MODP = 3 * MiB;
constexpr size_t WS_ROPE = 6 * MiB;
constexpr size_t WS_WIN = 14 * MiB;
constexpr size_t WS_WOUT = 43 * MiB;
constexpr size_t WS_H = 52 * MiB;
constexpr size_t WS_PROJ = 116 * MiB;
constexpr size_t WS_RS = 340 * MiB;
constexpr size_t WS_HS = 372 * MiB;
constexpr size_t WS_END = 436 * MiB;
static_assert(WS_WIN + (size_t)NIN * D * 2 <= WS_WOUT && WS_WOUT + (size_t)D * D * 2 <= WS_H && WS_H + (size_t)M * D * 2 <= WS_PROJ && WS_PROJ + (size_t)M * NIN * 2 <= WS_RS &&
              WS_RS + (size_t)BATCH * RN * RH * RDV * RDK * 2 <= WS_HS && WS_HS + (size_t)BATCH * HN * HH * HDV * HDK * 2 <= WS_END && WS_MODP + (size_t)MOD_KS * BATCH * NMOD * 4 <= WS_ROPE &&
              WS_ROPE + (size_t)BATCH * T * 128 * 4 <= WS_WIN, "d_ws map");
constexpr int CW_BAR = 1024;

constexpr int RING_OFF = 0, RING_BYTES = 131072;
constexpr int LDSCTL_OFF = RING_BYTES, MISC_OFF = LDSCTL_OFF + 320;
constexpr int LDS_BYTES = 147456;

#define GAS __attribute__((address_space(1)))
#define LAS __attribute__((address_space(3)))
typedef unsigned short bf16;
typedef unsigned v4u __attribute__((ext_vector_type(4)));
typedef unsigned v2u __attribute__((ext_vector_type(2)));
typedef float f32x4 __attribute__((ext_vector_type(4)));
typedef GAS unsigned gu32;
#define RLX_AGENT __ATOMIC_RELAXED, __HIP_MEMORY_SCOPE_AGENT
#define LDS_WAIT() asm volatile("s_waitcnt lgkmcnt(0)" ::: "memory")
#define VM_WAIT() asm volatile("s_waitcnt vmcnt(0)" ::: "memory")
__device__ __forceinline__ unsigned f2bf(float f) { unsigned u = __builtin_bit_cast(unsigned, f); return (u + 0x7fffu + ((u >> 16) & 1u)) >> 16; }
__device__ __forceinline__ unsigned pk2(float lo, float hi) { return f2bf(lo) | (f2bf(hi) << 16); }
__device__ __forceinline__ float bf2f(unsigned short b) { return __builtin_bit_cast(float, (unsigned)b << 16); }
__device__ __forceinline__ float bflo(unsigned w) { return __builtin_bit_cast(float, w << 16); }
__device__ __forceinline__ float bfhi(unsigned w) { return __builtin_bit_cast(float, w & 0xffff0000u); }
__device__ __forceinline__ float wave_sum(float v) {
#pragma unroll
    for (int o = 1; o < 64; o <<= 1) v += __shfl_xor(v, o);
    return v;
}
__device__ __forceinline__ float sigmoidf_(float x) { return 1.0f / (1.0f + __expf(-x)); }
__device__ __forceinline__ float siluf_(float x) { return x / (1.0f + __expf(-x)); }
__device__ __forceinline__ float ret_log2_gamma(int h) {
    const float e = (float)(5.0 + 7.0 * (double)h / 3.0);
    return log1pf(-exp2f(-e)) * 1.4426950408889634f;
}
#define XB_TMO      128
#define XB_XCNT(j)  (256  + 64 * (j))
#define XB_XSUB(j)  (1280 + 64 * (j))
#define XB_XGEN(j)  (2304 + 64 * (j))
#define XB_TOP      3328
#define XB_TOPGEN   3392
#define XCD_BAR_WORDS 3456
#define XB_SPIN_CAP (1u << 18)

__device__ __forceinline__ unsigned xb_ld(unsigned* p)              { return __hip_atomic_load(p, __ATOMIC_RELAXED, __HIP_MEMORY_SCOPE_AGENT); }
__device__ __forceinline__ unsigned xb_add(unsigned* p, unsigned v) { return __hip_atomic_fetch_add(p, v, __ATOMIC_RELAXED, __HIP_MEMORY_SCOPE_AGENT); }
__device__ __forceinline__ unsigned xb_xcc_id() { return (unsigned)__builtin_amdgcn_s_getreg((3 << 11) | 20) & 0xFu; }
#define XB_SPIN(cond, bar) do { unsigned _sp = 0; while (cond) { __builtin_amdgcn_s_sleep(1); \
    if ((++_sp & 255u) == 0u) { if (xb_ld(&(bar)[XB_TMO])) break; if (_sp > XB_SPIN_CAP) { atomicAdd(&(bar)[XB_TMO], 1u); break; } } } } while (0)

struct XcdBarrier {
    unsigned* bar; unsigned x;
    volatile LAS unsigned* st;
};

__device__ __forceinline__ XcdBarrier xcd_barrier_post(unsigned* bar, volatile LAS unsigned* st) {
    XcdBarrier b; b.bar = bar; b.x = xb_xcc_id(); b.st = st;
    if (threadIdx.x == 0) (void)xb_add(&bar[XB_XCNT(b.x)], 1u);
    return b;
}
__device__ __forceinline__ void xcd_barrier_complete(unsigned* bar, unsigned x, unsigned& nloc, unsigned& nx) {
    const unsigned G = gridDim.x * gridDim.y * gridDim.z;
    unsigned sum, cnt, mine, sp = 0u;
    for (;;) {
        sum = 0u; cnt = 0u; mine = 0u;
#pragma unroll
        for (unsigned j = 0; j < 16; ++j) { const unsigned c = xb_ld(&bar[XB_XCNT(j)]); sum += c; cnt += (c > 0u) ? 1u : 0u; mine = (j == x) ? c : mine; }
        if (sum == G) break;
        __builtin_amdgcn_s_sleep(1);
        if ((++sp & 255u) == 0u) { if (xb_ld(&bar[XB_TMO])) break; if (sp > XB_SPIN_CAP) { atomicAdd(&bar[XB_TMO], 1u); break; } }
    }
    nloc = mine > 0u ? mine : 1u; nx = cnt > 0u ? cnt : 1u;
}

__device__ __forceinline__ void xcd_barrier(const XcdBarrier& b) {
    asm volatile("s_waitcnt vmcnt(0)" ::: "memory");
    __syncthreads();
    if (threadIdx.x == 0) {
        unsigned* bar = b.bar;
        __builtin_amdgcn_s_waitcnt(0);
        unsigned nloc = b.st[0], nx = b.st[1];
        if (nloc == 0u) { xcd_barrier_complete(bar, b.x, nloc, nx); b.st[0] = nloc; b.st[1] = nx; }
        const unsigned old = xb_add(&bar[XB_XSUB(b.x)], 1u);
        const unsigned gen = old / nloc;
        if (old + 1u == (gen + 1u) * nloc) {
            __builtin_amdgcn_fence(__ATOMIC_RELEASE, "agent");
            asm volatile("s_waitcnt vmcnt(0)" ::: "memory");
            const unsigned og = xb_add(&bar[XB_TOP], 1u);
            const unsigned tg = og / nx;
            if (og + 1u == (tg + 1u) * nx) xb_add(&bar[XB_TOPGEN], 1u);
            else XB_SPIN(xb_ld(&bar[XB_TOPGEN]) == tg, bar);
            __builtin_amdgcn_fence(__ATOMIC_ACQUIRE, "agent");
            xb_add(&bar[XB_XGEN(b.x)], 1u);
            asm volatile("s_waitcnt vmcnt(0)" ::: "memory");
        } else {
            XB_SPIN(xb_ld(&bar[XB_XGEN(b.x)]) == gen, bar);
            __builtin_amdgcn_fence(__ATOMIC_ACQUIRE, "agent");
            asm volatile("s_waitcnt vmcnt(0)" ::: "memory");
        }
    }
    __syncthreads();
}

struct Frame {
    LAS unsigned char* lds;
    volatile LAS unsigned* MISC;
    gu32* ctl;
    int tid, lane, wave, vcu, G;
    const float *x, *c, *w_ada, *b_ada, *w_in, *lb_logits, *hg_norm_w, *w_out, *ln_w, *ln_b;
    const int* positions;
    float* out;
    float *LB, *GATE, *LAM, *MODP, *ROPE;
    bf16 *WIN, *WOUT, *HB, *PROJ, *RS, *HS;
};

#if defined(NAIVE_P3)
__device__ __forceinline__ int win_dst_row(int n) { return n; }
#else
__device__ __forceinline__ int win_dst_row(int n) {
    int pn, bj, wc, fq, nn, j;
    if (n < 1024) { const int sec = n >> 9, m = n & 511, head = m >> 7, dim = m & 127, i = dim & 63;
        bj = dim >> 6; wc = 2 * (head & 1) + (i >> 5); fq = (i >> 3) & 3; nn = (i >> 2) & 1; j = i & 3; pn = 2 * sec + (head >> 1); }
    else if (n >= C_HQ && n < C_HI) { const int sec = (n - C_HQ) >> 10, m = (n - C_HQ) & 1023, h = m >> 7, d = m & 127;
        bj = sec; wc = d >> 5; fq = (d >> 3) & 3; nn = (d >> 2) & 1; j = d & 3; pn = 12 + h; }
    else { const int c = n & 255; pn = n >> 8; bj = c >> 7; wc = (c >> 5) & 3; fq = (c >> 3) & 3; nn = (c >> 2) & 1; j = c & 3; }
    return 256 * pn + 128 * bj + 32 * wc + 16 * nn + 4 * fq + j;
}
#endif
__device__ __forceinline__ float win_col_scale(int n) { return n < C_RK ? 0.08838834764831845f : 1.0f; }

template <bool IS_WIN>
__device__ __forceinline__ void p0_transpose_item(const float* W, int K, int N, bf16* WT, LAS float* scr, int item, int lane) {
    const int nblk = N / 32, kb = item / nblk, nb = item % nblk, k0 = 64 * kb, n0 = 32 * nb;
    const int lr = lane >> 3, lc = (lane & 7) * 4;
    f32x4 t[8];
#pragma unroll
    for (int i = 0; i < 8; ++i) t[i] = *(const GAS f32x4*)(W + (size_t)(k0 + 8 * i + lr) * N + n0 + lc);
#pragma unroll
    for (int i = 0; i < 8; ++i) { LAS float* d = scr + (8 * i + lr) * 33 + lc; d[0] = t[i].x; d[1] = t[i].y; d[2] = t[i].z; d[3] = t[i].w; }
    LDS_WAIT(); asm volatile("" ::: "memory");
    const int c = lane & 7;
#pragma unroll
    for (int j = 0; j < 4; ++j) { const int n = (lane >> 3) + 8 * j; const LAS float* s = scr + (8 * c) * 33 + n;
        const float sc = IS_WIN ? win_col_scale(n0 + n) : 1.0f; const int drow = IS_WIN ? win_dst_row(n0 + n) : (n0 + n);
        v4u o; o.x = pk2(s[0 * 33] * sc, s[1 * 33] * sc); o.y = pk2(s[2 * 33] * sc, s[3 * 33] * sc); o.z = pk2(s[4 * 33] * sc, s[5 * 33] * sc); o.w = pk2(s[6 * 33] * sc, s[7 * 33] * sc);
        *(GAS v4u*)(WT + (size_t)drow * K + k0 + 8 * c) = o; }
    LDS_WAIT(); asm volatile("" ::: "memory");
}

constexpr int GEMV_CB = NMOD / 256, GEMV_ITEMS = MOD_KS * GEMV_CB;
__device__ __forceinline__ void p0_prologue(Frame& F) {
    for (int it = F.vcu; it < GEMV_ITEMS; it += F.G) {
        constexpr int KS = D / MOD_KS, KW = KS / NWAVES;
        const int s = it / GEMV_CB, cb = it % GEMV_CB, k0 = s * KS, n0 = cb * 256 + 4 * F.lane;
        LAS float* sc = (LAS float*)(F.lds + RING_OFF);
        LAS float* red = sc + BATCH * KS;
        __syncthreads();
        for (int i = F.tid; i < BATCH * KS; i += NTHR) { const int b = i / KS, k = i % KS; sc[i] = siluf_(F.c[(size_t)b * D + k0 + k]); }
        __syncthreads();
        f32x4 acc[BATCH];
#pragma unroll
        for (int b = 0; b < BATCH; ++b) acc[b] = (f32x4){0.f, 0.f, 0.f, 0.f};
        for (int i0 = 0; i0 < KW; i0 += 8) {
            f32x4 w[8];
#pragma unroll
            for (int i = 0; i < 8; ++i) w[i] = *(const GAS f32x4*)(F.w_ada + (size_t)(k0 + F.wave + 8 * (i0 + i)) * NMOD + n0);
#pragma unroll
            for (int i = 0; i < 8; ++i)
#pragma unroll
                for (int b = 0; b < BATCH; ++b) acc[b] += w[i] * sc[b * KS + F.wave + 8 * (i0 + i)];
        }
#pragma unroll
        for (int b = 0; b < BATCH; ++b) *(LAS f32x4*)(red + (F.wave * BATCH + b) * 256 + 4 * F.lane) = acc[b];
        __syncthreads();
        for (int i = F.tid; i < BATCH * 256; i += NTHR) { const int b = i >> 8, col = i & 255; float t = (s == 0) ? F.b_ada[cb * 256 + col] : 0.f;
#pragma unroll
            for (int w = 0; w < NWAVES; ++w) t += red[(w * BATCH + b) * 256 + col];
            F.MODP[((size_t)s * BATCH + b) * NMOD + cb * 256 + col] = t; }
        __syncthreads();
    }
    {
        LAS float* scr = (LAS float*)(F.lds + RING_OFF + F.wave * 16384);
        const int gw = (F.G - 1 - F.vcu) * NWAVES + F.wave, NGW = F.G * NWAVES;
        constexpr int I_IN = (D / 64) * (NIN / 32), I_OUT = (D / 64) * (D / 32);
        for (int it = gw; it < I_IN + I_OUT; it += NGW) {
            if (it < I_IN) p0_transpose_item<true>(F.w_in, D, NIN, F.WIN, scr, it, F.lane);
            else p0_transpose_item<false>(F.w_out, D, D, F.WOUT, scr, it - I_IN, F.lane);
        }
    }
    {
        const int gt = blockIdx.x * NTHR + F.tid, NGT = F.G * NTHR;
        const float freq = (float)pow(10000.0, -(double)(gt & 63) / 64.0);
        for (int idx = gt; idx < BATCH * T * 64; idx += NGT) {
            const int i = idx & 63, bt = idx >> 6;
            const float ang = (float)F.positions[bt] * freq;
            float sn, cs; sincosf(ang, &sn, &cs);
            F.ROPE[(size_t)bt * 128 + i] = cs; F.ROPE[(size_t)bt * 128 + 64 + i] = sn;
        }
        for (int idx = gt; idx < HH * HDK; idx += NGT) { const float l0 = F.lb_logits[idx], l1 = F.lb_logits[HH * HDK + idx]; const float mx = fmaxf(l0, l1);
            const float e0 = expf(l0 - mx), e1 = expf(l1 - mx); F.LB[idx] = e0 / (e0 + e1); }
    }
}

__device__ __forceinline__ void p1_modulate(Frame& F) {
    LAS float* sh = (LAS float*)(F.lds + RING_OFF);
    constexpr int ROWS_WG = 64;
    for (int blk = blockIdx.x; blk < M / ROWS_WG; blk += F.G) {
        const int b = (blk * ROWS_WG) / T;
        __syncthreads();
        for (int i = F.tid; i < 2 * D; i += NTHR) { float s = 0.f;
#pragma unroll
            for (int ks = 0; ks < MOD_KS; ++ks) s += F.MODP[((size_t)ks * BATCH + b) * NMOD + i];
            sh[i] = s; }
        if ((blk * ROWS_WG) % T == 0) {
            for (int i = F.tid; i < D; i += NTHR) { float s = 0.f;
#pragma unroll
                for (int ks = 0; ks < MOD_KS; ++ks) s += F.MODP[((size_t)ks * BATCH + b) * NMOD + 2 * D + i];
                F.GATE[(size_t)b * D + i] = s; }
        }
        __syncthreads();
        for (int r = F.wave; r < ROWS_WG; r += NWAVES) {
            const int row = blk * ROWS_WG + r;
            const GAS f32x4* xr = (const GAS f32x4*)(F.x + (size_t)row * D) + F.lane;
            f32x4 v[8]; float s = 0.f;
#pragma unroll
            for (int j = 0; j < 8; ++j) { v[j] = xr[64 * j]; s += (v[j].x + v[j].y) + (v[j].z + v[j].w); }
            const float mean = wave_sum(s) * (1.f / D); float s2 = 0.f;
#pragma unroll
            for (int j = 0; j < 8; ++j) { v[j] = v[j] - mean; s2 += (v[j].x * v[j].x + v[j].y * v[j].y) + (v[j].z * v[j].z + v[j].w * v[j].w); }
            const float rstd = 1.f / sqrtf(wave_sum(s2) * (1.f / D) + EPS);
            GAS v2u* o8 = (GAS v2u*)(F.HB + (size_t)row * D) + F.lane;
#pragma unroll
            for (int j = 0; j < 8; ++j) { const int c0 = 4 * F.lane + 256 * j;
                const f32x4 sf = *(const LAS f32x4*)(sh + c0), sc = *(const LAS f32x4*)(sh + D + c0);
                const f32x4 h = v[j] * rstd * (sc + 1.0f) + sf;
                v2u w; w.x = pk2(h.x, h.y); w.y = pk2(h.z, h.w); o8[64 * j] = w; }
        }
    }
    __syncthreads();
}

__device__ __forceinline__ void p3_transform_naive(Frame& F) {
    const long gt = (long)blockIdx.x * NTHR + F.tid, NGT = (long)F.G * NTHR;
    for (long idx = gt; idx < (long)M * 512; idx += NGT) {
        const int i = idx & 63, head = (idx >> 6) & 3, which = (idx >> 8) & 1; const int row = (int)(idx >> 9);
        bf16* p = F.PROJ + (size_t)row * NIN + (which ? C_RK : C_RQ) + head * RDK + i;
        const float x1 = bf2f(p[0]), x2 = bf2f(p[64]);
        const float cs = F.ROPE[(size_t)row * 128 + i], sn = F.ROPE[(size_t)row * 128 + 64 + i];
        const int tl = row % RC;
        const float lg = ret_log2_gamma(head);
        const float sc = exp2f((which ? -1.f : 1.f) * (float)(tl + 1) * lg);
        p[0] = (bf16)f2bf((x1 * cs - x2 * sn) * sc); p[64] = (bf16)f2bf((x1 * sn + x2 * cs) * sc);
    }
    for (long idx = gt; idx < (long)M * 2048; idx += NGT) {
        const int cc = idx & 2047; const int row = (int)(idx >> 11);
        bf16* p = F.PROJ + (size_t)row * NIN + (cc < 1024 ? C_RG + cc : C_HG + cc - 1024);
        p[0] = (bf16)f2bf(siluf_(bf2f(p[0])));
    }
    for (long idx = gt; idx < (long)BATCH * HN * HH * HDK; idx += NGT) {
        const int d = idx & 127, h = (idx >> 7) & 7, n = (idx >> 10) & 31, b = (int)(idx >> 15);
        const float lb = F.LB[h * HDK + d];
        float bs = 0.f;
        for (int s = 0; s < HC; ++s) {
            const size_t row = (size_t)b * T + n * HC + s;
            bf16* pq = F.PROJ + row * NIN + C_HQ + h * HDK + d; bf16* pf = F.PROJ + row * NIN + C_HF + h * HDK + d;
            const float q = bf2f(pq[0]), fp = bf2f(pf[0]);
            const float sg = 1.0f / (1.0f + expf(-fp)), sgn = 1.0f / (1.0f + expf(fp));
            const float f = lb + (1.0f - lb) * sg;
            bs += logf(f);
            pq[0] = (bf16)f2bf(q * expf(bs)); pf[0] = (bf16)f2bf((1.0f - lb) * sgn * expf(-bs));
        }
        F.LAM[idx] = expf(bs);
    }
}

__device__ __forceinline__ void p4_state_naive(Frame& F) {
    const long gt = (long)blockIdx.x * NTHR + F.tid, NGT = (long)F.G * NTHR;
    for (long idx = gt; idx < (long)BATCH * RH * RDV * RDK; idx += NGT) {
        const int d = idx & 127, e = (idx >> 7) & 255, h = (idx >> 15) & 3, b = (int)(idx >> 17);
        const float cd = exp2f((float)RC * ret_log2_gamma(h));
        float S = 0.f;
        for (int n = 0; n < RN; ++n) {
            F.RS[((((size_t)b * RN + n) * RH + h) * RDV + e) * RDK + d] = (bf16)f2bf(S);
            for (int j = 0; j < RC; ++j) { const size_t row = (size_t)b * T + n * RC + j;
                S += bf2f(F.PROJ[row * NIN + C_RK + h * RDK + d]) * bf2f(F.PROJ[row * NIN + C_RV + h * RDV + e]); }
            S *= cd;
        }
    }
    for (long idx = gt; idx < (long)BATCH * HH * HDV * HDK; idx += NGT) {
        const int d = idx & 127, e = (idx >> 7) & 127, h = (idx >> 14) & 7, b = (int)(idx >> 17);
        float S = 0.f;
        for (int n = 0; n < HN; ++n) {
            F.HS[((((size_t)b * HN + n) * HH + h) * HDV + e) * HDK + d] = (bf16)f2bf(S);
            for (int j = 0; j < HC; ++j) { const size_t row = (size_t)b * T + n * HC + j;
                S += bf2f(F.PROJ[row * NIN + C_HF + h * HDK + d]) * bf2f(F.PROJ[row * NIN + C_HI + h * HDV + e]); }
            S *= F.LAM[(((size_t)b * HN + n) * HH + h) * HDK + d];
        }
    }
}

template <int C, int DV>
__device__ __forceinline__ void p5_item_naive(Frame& F, const bf16* qt, const bf16* kt, const bf16* v, const bf16* g, const bf16* ST, const float* nw, bf16* mixed) {
    LAS float* P = (LAS float*)(F.lds + RING_OFF);
    LAS float* O = P + C * (C + 1);
    __syncthreads();
    for (int idx = F.tid; idx < C * C; idx += NTHR) {
        const int i = idx / C, j = idx % C; float s = 0.f;
        if (j <= i) { const v4u* a = (const v4u*)(qt + (size_t)i * NIN); const v4u* bq = (const v4u*)(kt + (size_t)j * NIN);
            for (int k = 0; k < 16; ++k) { const v4u av = a[k], bv = bq[k];
                s += bflo(av.x) * bflo(bv.x) + bfhi(av.x) * bfhi(bv.x) + bflo(av.y) * bflo(bv.y) + bfhi(av.y) * bfhi(bv.y)
                   + bflo(av.z) * bflo(bv.z) + bfhi(av.z) * bfhi(bv.z) + bflo(av.w) * bflo(bv.w) + bfhi(av.w) * bfhi(bv.w); } }
        P[i * (C + 1) + j] = s;
    }
    __syncthreads();
    for (int i0 = 0; i0 < C; i0 += 32) {
        const int ii = F.tid >> 4, el = F.tid & 15, i = i0 + ii;
        for (int e = el; e < DV; e += 16) {
            float s = 0.f;
            for (int j = 0; j <= i; ++j) s += P[i * (C + 1) + j] * bf2f(v[(size_t)j * NIN + e]);
            const v4u* a = (const v4u*)(qt + (size_t)i * NIN); const v4u* st = (const v4u*)(ST + (size_t)e * 128);
            for (int k = 0; k < 16; ++k) { const v4u av = a[k], bv = st[k];
                s += bflo(av.x) * bflo(bv.x) + bfhi(av.x) * bfhi(bv.x) + bflo(av.y) * bflo(bv.y) + bfhi(av.y) * bfhi(bv.y)
                   + bflo(av.z) * bflo(bv.z) + bfhi(av.z) * bfhi(bv.z) + bflo(av.w) * bflo(bv.w) + bfhi(av.w) * bfhi(bv.w); }
            O[ii * DV + e] = s;
        }
        __syncthreads();
        for (int r = F.wave; r < 32; r += NWAVES) {
            float ss = 0.f;
            for (int e = F.lane; e < DV; e += 64) { const float o = O[r * DV + e]; ss += o * o; }
            const float rstd = 1.0f / sqrtf(wave_sum(ss) * (1.0f / DV) + EPS);
            for (int e = F.lane; e < DV; e += 64) { const float o = O[r * DV + e] * rstd * (nw ? nw[e] : 1.0f) * bf2f(g[(size_t)(i0 + r) * NIN + e]);
                mixed[(size_t)(i0 + r) * D + e] = (bf16)f2bf(o); }
        }
        __syncthreads();
    }
}
__device__ __forceinline__ void p5_output_naive(Frame& F) {
    constexpr int NR = BATCH * RN * RH, NHI = BATCH * HN * HH;
    for (int it = blockIdx.x; it < NR + NHI; it += F.G) {
        if (it < NR) { const int h = it % RH, n = (it / RH) % RN, b = it / (RH * RN); const size_t row0 = (size_t)b * T + n * RC;
            const bf16* base = F.PROJ + row0 * NIN;
            p5_item_naive<RC, RDV>(F, base + C_RQ + h * RDK, base + C_RK + h * RDK, base + C_RV + h * RDV, base + C_RG + h * RDV,
                                   F.RS + (((size_t)b * RN + n) * RH + h) * RDV * RDK, nullptr, F.HB + row0 * D + h * RDV);
        } else { const int i2 = it - NR; const int h = i2 % HH, n = (i2 / HH) % HN, b = i2 / (HH * HN); const size_t row0 = (size_t)b * T + n * HC;
            const bf16* base = F.PROJ + row0 * NIN;
            p5_item_naive<HC, HDV>(F, base + C_HQ + h * HDK, base + C_HF + h * HDK, base + C_HI + h * HDV, base + C_HG + h * HDV,
                                   F.HS + (((size_t)b * HN + n) * HH + h) * HDV * HDK, F.hg_norm_w + h * HDV, F.HB + row0 * D + RH * RDV + h * HDV);
        }
    }
    __syncthreads();
}

__device__ __forceinline__ void p7_final_ln(Frame& F) {
    const int gw = F.vcu * NWAVES + F.wave, NGW = F.G * NWAVES;
    for (int row = gw; row < M; row += NGW) {
        GAS f32x4* zr = (GAS f32x4*)(F.out + (size_t)row * D) + F.lane;
        f32x4 v[8]; float s = 0.f;
#pragma unroll
        for (int j = 0; j < 8; ++j) { v[j] = zr[64 * j]; s += (v[j].x + v[j].y) + (v[j].z + v[j].w); }
        const float mean = wave_sum(s) * (1.f / D); float s2 = 0.f;
#pragma unroll
        for (int j = 0; j < 8; ++j) { v[j] = v[j] - mean; s2 += (v[j].x * v[j].x + v[j].y * v[j].y) + (v[j].z * v[j].z + v[j].w * v[j].w); }
        const float rstd = 1.f / sqrtf(wave_sum(s2) * (1.f / D) + EPS);
#pragma unroll
        for (int j = 0; j < 8; ++j) { const int c0 = 4 * F.lane + 256 * j;
            const f32x4 w = *(const f32x4*)(F.ln_w + c0), bb = *(const f32x4*)(F.ln_b + c0);
            zr[64 * j] = v[j] * rstd * w + bb; }
    }
}

typedef short bf16x8 __attribute__((ext_vector_type(8)));
typedef short s16x4 __attribute__((ext_vector_type(4)));
typedef float f32x16 __attribute__((ext_vector_type(16)));
#define MFMA32(a, b, c) __builtin_amdgcn_mfma_f32_32x32x16_bf16((a), (b), (c), 0, 0, 0)
__device__ __forceinline__ int rimg(int row, int col) { return row * 256 + ((col * 2) ^ ((row & 15) << 4)); }
__device__ __forceinline__ int timg(int row, int col) { return row * 256 + ((col * 2) ^ ((row & 3) << 6)); }
__device__ __forceinline__ s16x4 ds_tr(const LAS unsigned char* p) { typedef short v4s __attribute__((ext_vector_type(4))); return __builtin_amdgcn_ds_read_tr16_b64_v4i16((LAS v4s*)p); }
__device__ __forceinline__ bf16x8 frag_tr(const LAS unsigned char* img, int k0, int c0, int lane) {
    const int h = lane >> 5, g1 = (lane >> 4) & 1, q = (lane >> 2) & 3, p = lane & 3;
    const s16x4 lo = ds_tr(img + timg(k0 + 8 * h + q, c0 + 16 * g1 + 4 * p));
    const s16x4 hi = ds_tr(img + timg(k0 + 8 * h + 4 + q, c0 + 16 * g1 + 4 * p));
    return __builtin_shufflevector(lo, hi, 0, 1, 2, 3, 4, 5, 6, 7);
}
template <int R, int NC, bool TR>
__device__ __forceinline__ void tile_to_lds(LAS unsigned char* img, const bf16* g, int pitch, int tid) {
    constexpr int PR = NC / 8;
#pragma unroll
    for (int idx0 = 0; idx0 < R * PR; idx0 += NTHR) { const int idx = idx0 + tid; const int row = idx / PR, c8 = idx % PR;
        const v4u t = *(const v4u*)(g + (size_t)row * pitch + c8 * 8);
        *(LAS v4u*)(img + (TR ? timg(row, c8 * 8) : rimg(row, c8 * 8))) = t; }
}

constexpr int P5_R0 = 0, P5_R1 = 32768, P5_R2 = 65536, P5_R3 = 98304, P5_RED = LDSCTL_OFF + 1024;
template <int C, int DV>
__device__ __forceinline__ void p5_item(Frame& F, const bf16* qt, const bf16* kt, const bf16* v, const bf16* g, const bf16* ST, const float* nw, bf16* mixed) {
    constexpr int NIB = C / 32, NEH = DV / 128;
    constexpr int NIW = NIB / 2;
    LAS unsigned char* R0 = F.lds + P5_R0; LAS unsigned char* R1 = F.lds + P5_R1; LAS unsigned char* R2 = F.lds + P5_R2; LAS unsigned char* R3 = F.lds + P5_R3;
    LAS float* RED = (LAS float*)(F.lds + P5_RED);
    const int lane = F.lane, w = F.wave, r = lane & 31, h = lane >> 5, t = w & 3, q = w >> 2;
    __syncthreads();
    tile_to_lds<C, 128, false>(R0, qt, NIN, F.tid);
    tile_to_lds<C, 128, false>(R1, kt, NIN, F.tid);
    tile_to_lds<C, 128, true>(R2, v, NIN, F.tid);
    bf16x8 sf[8];
#pragma unroll
    for (int s = 0; s < 8; ++s) sf[s] = *(const bf16x8*)(ST + (size_t)(32 * t + r) * 128 + 16 * s + 8 * h);
    __syncthreads();
    for (int blk = w; blk < NIB * NIB; blk += NWAVES) {
        const int ib = blk / NIB, jb = blk % NIB;
        if (jb > ib) continue;
        f32x16 X;
#pragma unroll
        for (int i = 0; i < 16; ++i) X[i] = 0.f;
#pragma unroll
        for (int s = 0; s < 8; ++s) {
            const bf16x8 a = *(const LAS bf16x8*)(R1 + rimg(jb * 32 + r, 16 * s + 8 * h));
            const bf16x8 b = *(const LAS bf16x8*)(R0 + rimg(ib * 32 + r, 16 * s + 8 * h));
            X = MFMA32(a, b, X);
        }
        if (jb == ib) {
#pragma unroll
            for (int rr = 0; rr < 16; ++rr) { const int j = (rr & 3) + 8 * (rr >> 2) + 4 * h; if (j > r) X[rr] = 0.f; }
        }
#pragma unroll
        for (int gq = 0; gq < 4; ++gq) { v2u pw; pw.x = pk2(X[4 * gq], X[4 * gq + 1]); pw.y = pk2(X[4 * gq + 2], X[4 * gq + 3]);
            *(LAS v2u*)(R3 + rimg(ib * 32 + r, jb * 32 + 8 * gq + 4 * h)) = pw; }
    }
    __syncthreads();
    v4u vh[(NEH == 2) ? (C * 16 / NTHR) : 1];
    if (NEH == 2) {
#pragma unroll
        for (int k = 0; k < C * 16 / NTHR; ++k) { const int idx = k * NTHR + F.tid; vh[k] = *(const v4u*)(v + (size_t)(idx / 16) * NIN + 128 + (idx % 16) * 8); }
    }
    f32x16 acc[NEH][NIW];
#pragma unroll
    for (int p = 0; p < NEH; ++p) {
        const LAS unsigned char* RV = (p == 0) ? R2 : R1;
        if (p == 1) {
#pragma unroll
            for (int k = 0; k < C * 16 / NTHR; ++k) { const int idx = k * NTHR + F.tid; *(LAS v4u*)(R1 + timg(idx / 16, (idx % 16) * 8)) = vh[k]; }
#pragma unroll
            for (int s = 0; s < 8; ++s) sf[s] = *(const bf16x8*)(ST + (size_t)(128 + 32 * t + r) * 128 + 16 * s + 8 * h);
            __syncthreads();
        }
#pragma unroll
        for (int iw = 0; iw < NIW; ++iw) {
            const int ib = q * NIW + iw;
            f32x16 a_;
#pragma unroll
            for (int i = 0; i < 16; ++i) a_[i] = 0.f;
            for (int jb = 0; jb <= ib; ++jb) {
#pragma unroll
                for (int s = 0; s < 2; ++s) {
                    const bf16x8 a = frag_tr(RV, jb * 32 + 16 * s, 32 * t, lane);
                    const bf16x8 b = *(const LAS bf16x8*)(R3 + rimg(ib * 32 + r, jb * 32 + 16 * s + 8 * h));
                    a_ = MFMA32(a, b, a_);
                }
            }
#pragma unroll
            for (int s = 0; s < 8; ++s) {
                const bf16x8 b = *(const LAS bf16x8*)(R0 + rimg(ib * 32 + r, 16 * s + 8 * h));
                a_ = MFMA32(sf[s], b, a_);
            }
            acc[p][iw] = a_;
        }
    }
    float ss[NIW];
#pragma unroll
    for (int iw = 0; iw < NIW; ++iw) { float s_ = 0.f;
#pragma unroll
        for (int p = 0; p < NEH; ++p)
#pragma unroll
            for (int i = 0; i < 16; ++i) s_ += acc[p][iw][i] * acc[p][iw][i];
        s_ += __shfl_xor(s_, 32);
        ss[iw] = s_; }
    if (h == 0) {
#pragma unroll
        for (int iw = 0; iw < NIW; ++iw) RED[w * 64 + iw * 32 + r] = ss[iw];
    }
    __syncthreads();
    float rstd[NIW];
#pragma unroll
    for (int iw = 0; iw < NIW; ++iw) { float s_ = 0.f;
#pragma unroll
        for (int tt = 0; tt < 4; ++tt) s_ += RED[(q * 4 + tt) * 64 + iw * 32 + r];
        rstd[iw] = 1.0f / sqrtf(s_ * (1.0f / DV) + EPS); }
#pragma unroll
    for (int p = 0; p < NEH; ++p)
#pragma unroll
        for (int iw = 0; iw < NIW; ++iw) { const int i = (q * NIW + iw) * 32 + r;
#pragma unroll
            for (int gq = 0; gq < 4; ++gq) { const int e = 128 * p + 32 * t + 8 * gq + 4 * h;
                const v2u gw = *(const v2u*)(g + (size_t)i * NIN + e);
                f32x4 o; o.x = acc[p][iw][4 * gq] * bflo(gw.x); o.y = acc[p][iw][4 * gq + 1] * bfhi(gw.x); o.z = acc[p][iw][4 * gq + 2] * bflo(gw.y); o.w = acc[p][iw][4 * gq + 3] * bfhi(gw.y);
                o = o * rstd[iw];
                if (nw) o = o * *(const f32x4*)(nw + e);
                v2u ow; ow.x = pk2(o.x, o.y); ow.y = pk2(o.z, o.w);
                *(v2u*)(mixed + (size_t)i * D + e) = ow; } }
}
__device__ __forceinline__ void p5_output(Frame& F) {
    constexpr int NR = BATCH * RN * RH, NHI = BATCH * HN * HH;
    for (int it = blockIdx.x; it < NR + NHI; it += F.G) {
        if (it < NR) { const int h = it % RH, n = (it / RH) % RN, b = it / (RH * RN); const size_t row0 = (size_t)b * T + n * RC;
            const bf16* base = F.PROJ + row0 * NIN;
            p5_item<RC, RDV>(F, base + C_RQ + h * RDK, base + C_RK + h * RDK, base + C_RV + h * RDV, base + C_RG + h * RDV,
                             F.RS + (((size_t)b * RN + n) * RH + h) * RDV * RDK, nullptr, F.HB + row0 * D + h * RDV);
        } else { const int i2 = it - NR; const int h = i2 % HH, n = (i2 / HH) % HN, b = i2 / (HH * HN); const size_t row0 = (size_t)b * T + n * HC;
            const bf16* base = F.PROJ + row0 * NIN;
            p5_item<HC, HDV>(F, base + C_HQ + h * HDK, base + C_HF + h * HDK, base + C_HI + h * HDV, base + C_HG + h * HDV,
                             F.HS + (((size_t)b * HN + n) * HH + h) * HDV * HDK, F.hg_norm_w + h * HDV, F.HB + row0 * D + RH * RDV + h * HDV);
        }
    }
    __syncthreads();
}

template <int C, int NCH, int DV, bool RET>
__device__ __forceinline__ void p4_unit(Frame& F, const bf16* kt, const bf16* v, bf16* ST, const float* lam, float cd) {
    constexpr size_t st_n = (size_t)(RET ? RH : HH) * DV * 128;
    constexpr int KP = C * 16 / NTHR, VP = C * 8 / NTHR;
    const int lane = F.lane, w = F.wave, r = lane & 31, h = lane >> 5, et = w & 1, dt = w >> 1;
    LAS unsigned char* buf[2] = {F.lds, F.lds + 65536};
    v4u kr[KP], vr[VP];
    f32x16 S;
#pragma unroll
    for (int i = 0; i < 16; ++i) S[i] = 0.f;
    __syncthreads();
#pragma unroll
    for (int k = 0; k < KP; ++k) { const int idx = k * NTHR + F.tid; *(LAS v4u*)(buf[0] + timg(idx / 16, (idx % 16) * 8)) = *(const v4u*)(kt + (size_t)(idx / 16) * NIN + (idx % 16) * 8); }
#pragma unroll
    for (int k = 0; k < VP; ++k) { const int idx = k * NTHR + F.tid; *(LAS v4u*)(buf[0] + 32768 + timg(idx / 8, (idx % 8) * 8)) = *(const v4u*)(v + (size_t)(idx / 8) * NIN + (idx % 8) * 8); }
    __syncthreads();
    for (int n = 0; n < NCH; ++n) {
        const LAS unsigned char* cb = buf[n & 1]; LAS unsigned char* nb = buf[(n + 1) & 1];
        if (n + 1 < NCH) {
            const bf16* ktn = kt + (size_t)(n + 1) * C * NIN; const bf16* vn = v + (size_t)(n + 1) * C * NIN;
#pragma unroll
            for (int k = 0; k < KP; ++k) { const int idx = k * NTHR + F.tid; kr[k] = *(const v4u*)(ktn + (size_t)(idx / 16) * NIN + (idx % 16) * 8); }
#pragma unroll
            for (int k = 0; k < VP; ++k) { const int idx = k * NTHR + F.tid; vr[k] = *(const v4u*)(vn + (size_t)(idx / 8) * NIN + (idx % 8) * 8); }
        }
        bf16* stp = ST + (size_t)n * st_n + (size_t)(32 * et + r) * 128 + 32 * dt + 4 * h;
#pragma unroll
        for (int gq = 0; gq < 4; ++gq) { v2u pw; pw.x = pk2(S[4 * gq], S[4 * gq + 1]); pw.y = pk2(S[4 * gq + 2], S[4 * gq + 3]); *(v2u*)(stp + 8 * gq) = pw; }
#pragma unroll
        for (int s = 0; s < C / 16; ++s) {
            const bf16x8 a = frag_tr(cb, 16 * s, 32 * dt, lane);
            const bf16x8 b = frag_tr(cb + 32768, 16 * s, 32 * et, lane);
            S = MFMA32(a, b, S);
        }
        if (RET) {
#pragma unroll
            for (int i = 0; i < 16; ++i) S[i] *= cd;
        } else {
            const float* lp = lam + (size_t)n * (HH * HDK) + 32 * dt + 4 * h;
#pragma unroll
            for (int gq = 0; gq < 4; ++gq) { const f32x4 l4 = *(const f32x4*)(lp + 8 * gq);
                S[4 * gq] *= l4.x; S[4 * gq + 1] *= l4.y; S[4 * gq + 2] *= l4.z; S[4 * gq + 3] *= l4.w; }
        }
        if (n + 1 < NCH) {
#pragma unroll
            for (int k = 0; k < KP; ++k) { const int idx = k * NTHR + F.tid; *(LAS v4u*)(nb + timg(idx / 16, (idx % 16) * 8)) = kr[k]; }
#pragma unroll
            for (int k = 0; k < VP; ++k) { const int idx = k * NTHR + F.tid; *(LAS v4u*)(nb + 32768 + timg(idx / 8, (idx % 8) * 8)) = vr[k]; }
        }
        __syncthreads();
    }
}
__device__ __forceinline__ void p4_state(Frame& F) {
    constexpr int NRU = BATCH * RH * (RDV / 64), NHU = BATCH * HH * (HDV / 64);
    for (int it = blockIdx.x; it < NRU + NHU; it += F.G) {
        if (it < NRU) { const int es = it % 4, h = (it / 4) % RH, b = it / (4 * RH);
            const bf16* base = F.PROJ + (size_t)b * T * NIN;
            p4_unit<RC, RN, RDV, true>(F, base + C_RK + h * RDK, base + C_RV + h * RDV + 64 * es, F.RS + (((size_t)b * RN) * RH + h) * RDV * RDK + (size_t)(64 * es) * 128, nullptr,
                                       exp2f((float)RC * ret_log2_gamma(h)));
        } else { const int i2 = it - NRU; const int es = i2 % 2, h = (i2 / 2) % HH, b = i2 / (2 * HH);
            const bf16* base = F.PROJ + (size_t)b * T * NIN;
            p4_unit<HC, HN, HDV, false>(F, base + C_HF + h * HDK, base + C_HI + h * HDV + 64 * es, F.HS + (((size_t)b * HN) * HH + h) * HDV * HDK + (size_t)(64 * es) * 128,
                                        F.LAM + ((size_t)b * HN * HH + h) * HDK, 1.0f);
        }
    }
    __syncthreads();
}

#ifndef REP_P0
#define REP_P0 1
#endif
#ifndef REP_P1
#define REP_P1 1
#endif
#ifndef REP_P2
#define REP_P2 1
#endif
#ifndef REP_P4
#define REP_P4 1
#endif
#ifndef REP_P5
#define REP_P5 1
#endif
#ifndef REP_P6
#define REP_P6 1
#endif
struct Args { const void* in[11]; float* out; unsigned char* ws; int ph_lo, ph_hi, li, pad; };
__global__ void __launch_bounds__(NTHR, 2) hymba_fwd(Args args) {
    extern __shared__ __attribute__((aligned(16))) unsigned char lds[];
    Frame F;
    F.lds = (LAS unsigned char*)lds;
    F.MISC = (volatile LAS unsigned*)(F.lds + MISC_OFF);
    F.tid = threadIdx.x; F.lane = F.tid & 63; F.wave = __builtin_amdgcn_readfirstlane(F.tid >> 6);
    F.G = gridDim.x; { const int bx = blockIdx.x; F.vcu = (F.G % 8 == 0) ? (bx % 8) * (F.G / 8) + bx / 8 : bx; }
    unsigned char* ws = args.ws;
    F.ctl = (gu32*)(ws + WS_CTL);
    F.x = (const float*)args.in[0]; F.c = (const float*)args.in[1]; F.positions = (const int*)args.in[2]; F.w_ada = (const float*)args.in[3]; F.b_ada = (const float*)args.in[4];
    F.w_in = (const float*)args.in[5]; F.lb_logits = (const float*)args.in[6]; F.hg_norm_w = (const float*)args.in[7]; F.w_out = (const float*)args.in[8];
    F.ln_w = (const float*)args.in[9]; F.ln_b = (const float*)args.in[10]; F.out = args.out;
    F.LB = (float*)(ws + WS_LB); F.GATE = (float*)(ws + WS_GATE); F.LAM = (float*)(ws + WS_LAM); F.MODP = (float*)(ws + WS_MODP); F.ROPE = (float*)(ws + WS_ROPE);
    F.WIN = (bf16*)(ws + WS_WIN); F.WOUT = (bf16*)(ws + WS_WOUT); F.HB = (bf16*)(ws + WS_H); F.PROJ = (bf16*)(ws + WS_PROJ); F.RS = (bf16*)(ws + WS_RS); F.HS = (bf16*)(ws + WS_HS);
    for (int u = F.tid; u < (LDS_BYTES - LDSCTL_OFF) / 4; u += NTHR) ((LAS unsigned*)(F.lds + LDSCTL_OFF))[u] = 0u;
    __syncthreads();
    XcdBarrier bar; bar.bar = (unsigned*)(F.ctl + CW_BAR); bar.x = 0; bar.st = nullptr;
    if (N_LAUNCHES != NPHASE) bar = xcd_barrier_post((unsigned*)(F.ctl + CW_BAR), F.MISC + 8);
#define GRID_BAR() do { if (N_LAUNCHES != NPHASE) xcd_barrier(bar); } while (0)
    const int lo = args.ph_lo, hi = args.ph_hi;
#define IN(k) (lo <= (k) && (k) < hi)
#define BOTH(k) (IN(k) && IN((k) + 1))

#if defined(PROBE_PHASE)
#ifndef PROBE_QUANT
#define PROBE_QUANT(x) (x)
#endif
    unsigned long long pt0 = 0, pt1 = 0;
#define PSTAMP0(k) do { if ((k) == PROBE_PHASE) pt0 = __builtin_amdgcn_s_memrealtime(); if ((k) > PROBE_PHASE && pt1 == 0) pt1 = __builtin_amdgcn_s_memrealtime(); } while (0)
#define PSTAMP1(k) do { if (pt1 == 0) pt1 = __builtin_amdgcn_s_memrealtime(); } while (0)
#else
#define PSTAMP0(k) do {} while (0)
#define PSTAMP1(k) do {} while (0)
#endif
    PSTAMP0(0);
    if (IN(0)) { for (int rep = 0; rep < REP_P0; ++rep) p0_prologue(F); if (BOTH(0)) GRID_BAR(); }
    PSTAMP0(1);
    if (IN(1)) { for (int rep = 0; rep < REP_P1; ++rep) p1_modulate(F); if (BOTH(1)) GRID_BAR(); }
    PSTAMP0(2);
    if (IN(2)) {
        pg8::Gemm g{F.HB, F.WIN, M, NIN, D}; pg8::StaticOrder S; S.init(M, NIN, F.G, (int)blockIdx.x);
#if defined(NAIVE_P3)
        pg8::EpiProj E{F.PROJ, NIN};
        pg8::gemm_phase<pg8::EpiProj, pg8::StaticOrder, true, true>(F.lds + RING_OFF, g, S, E);
#else
        pg8::EpiFused E{F.PROJ, NIN, F.ROPE, F.LB, F.LAM, ret_log2_gamma(0), ret_log2_gamma(1), ret_log2_gamma(2), ret_log2_gamma(3)};
        for (int rep = 0; rep < REP_P2; ++rep) pg8::gemm_phase<pg8::EpiFused, pg8::StaticOrder, true, true>(F.lds + RING_OFF, g, S, E);
#endif
        if (BOTH(2)) GRID_BAR();
    }
#if defined(NAIVE_P3)
    PSTAMP0(3);
    if (IN(3)) { p3_transform_naive(F); if (BOTH(3)) GRID_BAR(); }
#endif
    #if defined(NAIVE_P4)
    PSTAMP0(4);
    if (IN(4)) { p4_state_naive(F); if (BOTH(4)) GRID_BAR(); }
#else
    PSTAMP0(4);
    if (IN(4)) { for (int rep = 0; rep < REP_P4; ++rep) p4_state(F); if (BOTH(4)) GRID_BAR(); }
#endif
    #if defined(NAIVE_P5)
    PSTAMP0(5);
    if (IN(5)) { p5_output_naive(F); if (BOTH(5)) GRID_BAR(); }
#else
    PSTAMP0(5);
    if (IN(5)) { for (int rep = 0; rep < REP_P5; ++rep) p5_output(F); if (BOTH(5)) GRID_BAR(); }
#endif
    PSTAMP0(6);
    if (IN(6)) {
        pg8::Gemm g{F.HB, F.WOUT, M, D, D}; pg8::StaticOrder S; S.init(M, D, F.G, (int)blockIdx.x);
        pg8::EpiZ E{F.x, F.out, D, F.GATE, T, ALPHA};
        for (int rep = 0; rep < REP_P6; ++rep) pg8::gemm_phase<pg8::EpiZ, pg8::StaticOrder, true, true>(F.lds + RING_OFF, g, S, E);
        if (BOTH(6)) GRID_BAR();
    }
    PSTAMP0(7);
    if (IN(7)) { p7_final_ln(F); }
#if defined(PROBE_PHASE)
    PSTAMP1(7);
    GRID_BAR();
    if (blockIdx.x == 0 && F.tid == 0) F.out[0] = PROBE_QUANT((float)(pt1 - pt0) * 0.01f);
#endif
#undef IN
#undef BOTH
}

extern "C" void kernel_launch(void* const* d_in, const int* in_sizes, int n_in, void* d_out, int out_size, void* d_ws, size_t ws_size, hipStream_t stream) {
    static int grid = 0;
    if (grid == 0) {
        if (n_in != 11 || in_sizes[0] != M * D || out_size != M * D || ws_size < WS_END) { fprintf(stderr, "kernel_launch: unexpected shapes: n_in %d in0 %d out %d ws %zu (need %zu)\n", n_in, n_in > 0 ? in_sizes[0] : -1, out_size, ws_size, (size_t)WS_END); grid = -1; return; }
        int dev = 0, cus = 0, per_cu = 0;
        if (hipGetDevice(&dev) != hipSuccess || hipDeviceGetAttribute(&cus, hipDeviceAttributeMultiprocessorCount, dev) != hipSuccess) { fprintf(stderr, "kernel_launch: device query failed\n"); grid = -1; return; }
        if (hipFuncSetAttribute((const void*)hymba_fwd, hipFuncAttributeMaxDynamicSharedMemorySize, LDS_BYTES) != hipSuccess) { fprintf(stderr, "kernel_launch: hipFuncSetAttribute failed\n"); grid = -1; return; }
        if (hipOccupancyMaxActiveBlocksPerMultiprocessor(&per_cu, (const void*)hymba_fwd, NTHR, LDS_BYTES) != hipSuccess || per_cu < 1) { fprintf(stderr, "kernel_launch: occupancy query says %d workgroups per CU\n", per_cu); }
        (void)hipGetLastError();
        grid = cus;
    }
    if (grid < 0) return;
    if (hipMemsetAsync((char*)d_ws + WS_CTL, 0, CTL_ZERO_BYTES, stream) != hipSuccess) { fprintf(stderr, "kernel_launch: memset failed\n"); return; }
    Args a{};
    for (int i = 0; i < 11; ++i) a.in[i] = d_in[i];
    a.out = (float*)d_out; a.ws = (unsigned char*)d_ws;
    for (int li = 0; li < N_LAUNCHES; ++li) {
        a.ph_lo = (N_LAUNCHES == NPHASE) ? li : 0; a.ph_hi = (N_LAUNCHES == NPHASE) ? li + 1 : NPHASE; a.li = li;
        hipLaunchKernelGGL(hymba_fwd, dim3(grid), dim3(NTHR), LDS_BYTES, stream, a);
        const hipError_t le = hipPeekAtLastError();
        if (le != hipSuccess) { fprintf(stderr, "kernel_launch: launch %d failed: %s\n", li, hipGetErrorName(le)); break; }
    }
}
```
